# Optimizing an MI355X kernel written in HIP

```python
import math
import jax, jax.numpy as jnp
from jax import lax
import numpy as np

D_MODEL = 2048
BATCH = 2
SEQ = 4096
DEPTH = 2
DEC_BATCH = 16
DEC_SEQ = 16
PAST_LEN = 2048

CHUNK = 64
HEAD_DIM = 64
SWA_WINDOW = 128
SWA_BACK = SWA_WINDOW // CHUNK
SWA_HEADS = 16
SWA_KV_HEADS = 2
T5_BUCKETS = 32
T5_MAX_DIST = 128
RET_HEADS = 8
RET_DK = 64
RET_DV = 128
ROPE_BASE = 10000.0
RET_NORM_EPS = 1e-5
BAND_BACK = 8
BAND_HEADS = 16
BAND_MAX_REL = 256
MEM_LEN = 256
MEM_HEADS = 4
MEM_HD = D_MODEL // MEM_HEADS
MEM_W = MEM_HEADS * MEM_HD
D_FF = 5632
CONV_W = 3
DN_ALPHA = (2 * DEPTH) ** 0.25
DN_BETA = (8 * DEPTH) ** -0.25
LN_EPS = 1e-5

SWA_Q_W = SWA_HEADS * HEAD_DIM
SWA_KV_W = SWA_KV_HEADS * HEAD_DIM
RET_QK_W = RET_HEADS * RET_DK
RET_V_W = RET_HEADS * RET_DV
BAND_W = BAND_HEADS * HEAD_DIM
IN_WIDTHS = (SWA_Q_W, SWA_KV_W, SWA_KV_W, RET_QK_W, RET_QK_W, RET_V_W, RET_V_W,
             BAND_W, BAND_W, BAND_W, D_MODEL, D_MODEL, D_MODEL)
IN_COLS = sum(IN_WIDTHS)

kernel_name = "hybrid_streaming_encoder_step"

F32 = jnp.float32


def layer_norm(x, g, b):
    xf = x.astype(F32)
    mu = xf.mean(-1, keepdims=True)
    var = jnp.mean(jnp.square(xf - mu), -1, keepdims=True)
    return ((xf - mu) * lax.rsqrt(var + LN_EPS) * g.astype(F32) + b.astype(F32)).astype(x.dtype)


def rope(x, pos):
    half = x.shape[-1] // 2
    inv = ROPE_BASE ** (-jnp.arange(half, dtype=F32) / half)
    ang = pos.astype(F32)[:, None] * inv[None, :]
    cos = jnp.cos(ang)[None, :, None, :]
    sin = jnp.sin(ang)[None, :, None, :]
    x1 = x[..., :half].astype(F32)
    x2 = x[..., half:].astype(F32)
    return jnp.concatenate([x1 * cos - x2 * sin, x2 * cos + x1 * sin], -1).astype(x.dtype)


def t5_bucket(rel):
    nb = T5_BUCKETS // 2
    max_exact = nb // 2
    n = jnp.abs(rel)
    nf = jnp.maximum(n, 1).astype(F32)
    large = max_exact + (jnp.log(nf / max_exact) / math.log(T5_MAX_DIST / max_exact)
                         * (nb - max_exact)).astype(jnp.int32)
    large = jnp.minimum(large, nb - 1)
    return jnp.where(rel > 0, nb, 0) + jnp.where(n < max_exact, n, large)


def t5_bias(table, rel):
    return jnp.transpose(table[t5_bucket(rel)], (2, 0, 1)).astype(F32)


def clipped_rel_bias(table, rel):
    return table[:, jnp.clip(rel, -BAND_MAX_REL, BAND_MAX_REL) + BAND_MAX_REL].astype(F32)


def sink_softmax(s, sink):
    m = s.max(-1, keepdims=True)
    if sink is not None:
        m = jnp.maximum(m, sink)
    p = jnp.exp(s - m)
    den = p.sum(-1, keepdims=True)
    if sink is not None:
        den = den + jnp.exp(sink - m)
    return p / den


def band_attention(q, k, v, n_back, bias, sink):
    B, S, H, dh = q.shape
    G = k.shape[2]
    R = H // G
    nC = S // CHUNK
    qc = q.reshape(B, nC, CHUNK, G, R, dh)
    pad = ((0, 0), (n_back * CHUNK, 0), (0, 0), (0, 0))
    kc = jnp.pad(k, pad).reshape(B, nC + n_back, CHUNK, G, dh)
    vc = jnp.pad(v, pad).reshape(B, nC + n_back, CHUNK, G, dh)
    s = jnp.concatenate([jnp.einsum('bnqgrd,bnkgd->bngrqk', qc, kc[:, j:j + nC])
                         for j in range(n_back + 1)], axis=-1).astype(F32) * (dh ** -0.5)
    s = s + bias.reshape(G, R, CHUNK, -1)
    chunk_ok = (jnp.arange(nC)[:, None] + jnp.arange(n_back + 1)[None, :]) >= n_back
    key_ok = jnp.repeat(chunk_ok, CHUNK, axis=1)
    s = jnp.where(key_ok[None, :, None, None, None, :], s, -jnp.inf)
    sk = None if sink is None else sink.astype(F32).reshape(G, R, 1, 1)
    p = sink_softmax(s, sk).astype(v.dtype)
    o = sum(jnp.einsum('bngrqk,bnkgd->bnqgrd', p[..., j * CHUNK:(j + 1) * CHUNK], vc[:, j:j + nC])
            for j in range(n_back + 1))
    return o.reshape(B, S, H * dh)


def cached_attention(q, k, v, bias, sink):
    B, n, H, dh = q.shape
    G = k.shape[2]
    R = H // G
    s = jnp.einsum('bqgrd,bkgd->bgrqk', q.reshape(B, n, G, R, dh), k).astype(F32) * (dh ** -0.5)
    s = s + bias.reshape(G, R, n, -1)
    sk = None if sink is None else sink.astype(F32).reshape(G, R, 1, 1)
    p = sink_softmax(s, sk).astype(v.dtype)
    return jnp.einsum('bgrqk,bkgd->bqgrd', p, v).reshape(B, n, H * dh)


def ret_log_decay():
    return jnp.log(1.0 - 2.0 ** (-5.0 - jnp.arange(RET_HEADS, dtype=F32)))


def ret_block_output(q, k, v, s0, log_g):
    L = q.shape[2]
    i = jnp.arange(L, dtype=F32)
    diff = i[:, None] - i[None, :]
    decay = jnp.where(diff >= 0, jnp.exp(log_g[:, None, None] * jnp.maximum(diff, 0.0)), 0.0)
    qk = jnp.einsum('bnihd,bnjhd->bnhij', q, k).astype(F32) * decay
    o = jnp.einsum('bnhij,bnjhe->bnihe', qk, v.astype(F32))
    cross = jnp.exp(log_g[None, :] * (i[:, None] + 1.0))
    return o + jnp.einsum('bnihd,bnhde->bnihe', q.astype(F32), s0) * cross[:, :, None]


def ret_block_update(k, v, log_g):
    L = k.shape[2]
    i = jnp.arange(L, dtype=F32)
    w = jnp.exp(log_g[None, :] * (L - 1.0 - i)[:, None])
    return jnp.einsum('bnjhd,bnjhe->bnhde', k.astype(F32) * w[:, :, None], v.astype(F32))


def ret_finish(o, gate):
    mu = o.mean(-1, keepdims=True)
    var = jnp.mean(jnp.square(o - mu), -1, keepdims=True)
    o = (o - mu) * lax.rsqrt(var + RET_NORM_EPS)
    B, T = o.shape[:2]
    return (o.reshape(B, T, -1) * jax.nn.silu(gate.astype(F32))).astype(gate.dtype)


def project_in(x, w_in):
    B, T, _ = x.shape
    points = [int(p) for p in np.cumsum(IN_WIDTHS)[:-1]]
    qa, ka, va, qb, kb, vb, gr, qc, kc, vc, ga, gb, gc = jnp.split(x @ w_in, points, axis=-1)
    hd = lambda t, h: t.reshape(B, T, h, -1)
    return (hd(qa, SWA_HEADS), hd(ka, SWA_KV_HEADS), hd(va, SWA_KV_HEADS),
            hd(qb, RET_HEADS), hd(kb, RET_HEADS), hd(vb, RET_HEADS), gr,
            hd(qc, BAND_HEADS), hd(kc, BAND_HEADS), hd(vc, BAND_HEADS), ga, gb, gc)


def merge_branches(oa, ob, oc, ga, gb, gc, w_br_a, w_br_b, w_br_c, w_mix_o):
    mix = (jax.nn.sigmoid(ga) * (oa @ w_br_a) + jax.nn.sigmoid(gb) * (ob @ w_br_b)
           + jax.nn.sigmoid(gc) * (oc @ w_br_c))
    return mix @ w_mix_o


def mixer_prompt(x, w_in, t5_table, sink, band_table, w_br_a, w_br_b, w_br_c, w_mix_o):
    B, S, _ = x.shape
    qa, ka, va, qb, kb, vb, gr, qc, kc, vc, ga, gb, gc = project_in(x, w_in)
    nka = (SWA_BACK + 1) * CHUNK
    rel_a = jnp.arange(nka)[None, :] - SWA_BACK * CHUNK - jnp.arange(CHUNK)[:, None]
    oa = band_attention(qa, ka, va, SWA_BACK, t5_bias(t5_table, rel_a), sink)
    pos = jnp.arange(S)
    qb = rope(qb, pos)
    kb = rope(kb, pos) * (RET_DK ** -0.5)
    nC = S // CHUNK
    ch = lambda t: t.reshape(B, nC, CHUNK, RET_HEADS, -1)
    qr, kr, vr = ch(qb), ch(kb), ch(vb)
    log_g = ret_log_decay()
    upd = ret_block_update(kr, vr, log_g)
    g_chunk = jnp.exp(log_g * CHUNK)[:, None, None]

    def step(s, u):
        return g_chunk * s + u, s

    s_final, s_start = lax.scan(step, jnp.zeros((B, RET_HEADS, RET_DK, RET_DV), F32),
                                jnp.moveaxis(upd, 1, 0))
    o_r = ret_block_output(qr, kr, vr, jnp.moveaxis(s_start, 0, 1), log_g)
    ob = ret_finish(o_r.reshape(B, S, RET_HEADS, RET_DV), gr)
    nkc = (BAND_BACK + 1) * CHUNK
    rel_c = jnp.arange(nkc)[None, :] - BAND_BACK * CHUNK - jnp.arange(CHUNK)[:, None]
    oc = band_attention(qc, kc, vc, BAND_BACK, clipped_rel_bias(band_table, rel_c), None)
    out = merge_branches(oa, ob, oc, ga, gb, gc, w_br_a, w_br_b, w_br_c, w_mix_o)
    la = min(SWA_WINDOW, S)
    lc = min(BAND_BACK * CHUNK, S)
    return out, (ka[:, S - la:], va[:, S - la:], s_final, kc[:, S - lc:], vc[:, S - lc:])


def mixer_sample(x, swa_k, swa_v, ret_s, band_k, band_v, w_in, t5_table, sink, band_table,
                 w_br_a, w_br_b, w_br_c, w_mix_o):
    B, n, _ = x.shape
    qa, ka, va, qb, kb, vb, gr, qc, kc, vc, ga, gb, gc = project_in(x, w_in)
    qpos = PAST_LEN + jnp.arange(n)
    la = swa_k.shape[1]
    kpos_a = jnp.concatenate([PAST_LEN - la + jnp.arange(la), qpos])
    ka_all = jnp.concatenate([swa_k.astype(ka.dtype), ka], 1)
    va_all = jnp.concatenate([swa_v.astype(va.dtype), va], 1)
    oa = cached_attention(qa, ka_all, va_all, t5_bias(t5_table, kpos_a[None, :] - qpos[:, None]), sink)
    qb = rope(qb, qpos)
    kb = rope(kb, qpos) * (RET_DK ** -0.5)
    log_g = ret_log_decay()
    s0 = ret_s.astype(F32)
    o_r = ret_block_output(qb[:, None], kb[:, None], vb[:, None], s0[:, None], log_g)[:, 0]
    s_new = jnp.exp(log_g * n)[:, None, None] * s0 + ret_block_update(kb[:, None], vb[:, None], log_g)[:, 0]
    ob = ret_finish(o_r, gr)
    lc = band_k.shape[1]
    kpos_c = jnp.concatenate([PAST_LEN - lc + jnp.arange(lc), qpos])
    kc_all = jnp.concatenate([band_k.astype(kc.dtype), kc], 1)
    vc_all = jnp.concatenate([band_v.astype(vc.dtype), vc], 1)
    oc = cached_attention(qc, kc_all, vc_all,
                          clipped_rel_bias(band_table, kpos_c[None, :] - qpos[:, None]), None)
    out = merge_branches(oa, ob, oc, ga, gb, gc, w_br_a, w_br_b, w_br_c, w_mix_o)
    return out, (ka, va, s_new, kc, vc)


def mem_kv(mem, w_mk, w_mv):
    B, M, _ = mem.shape
    return ((mem @ w_mk).reshape(B, M, MEM_HEADS, MEM_HD), (mem @ w_mv).reshape(B, M, MEM_HEADS, MEM_HD))


def mem_attend(x, mk, mv, w_mq, w_mo):
    B, T, _ = x.shape
    q = (x @ w_mq).reshape(B, T, MEM_HEADS, MEM_HD)
    s = jnp.einsum('bqhd,bkhd->bhqk', q, mk.astype(q.dtype)).astype(F32) * (MEM_HD ** -0.5)
    p = jax.nn.softmax(s, axis=-1).astype(q.dtype)
    o = jnp.einsum('bhqk,bkhd->bqhd', p, mv.astype(q.dtype)).reshape(B, T, MEM_W)
    return o @ w_mo


def conv_ffn(x, conv_state, w_ffn_in, conv_w, conv_b, w_ffn_out):
    u = x @ w_ffn_in
    T = u.shape[1]
    up = jnp.concatenate([conv_state.astype(u.dtype), u], 1)
    c = sum(conv_w[j] * up[:, j:j + T] for j in range(CONV_W)) + conv_b
    g, val = jnp.split(c, 2, axis=-1)
    h = jax.nn.gelu(g, approximate=False) * val
    return h @ w_ffn_out, up[:, T:]


def setup_inputs(seed: int = 0) -> dict:
    key = jax.random.key(seed)
    ks = iter(jax.random.split(key, 40))
    nrm = lambda shape, scale: jax.random.normal(next(ks), shape, F32) * scale
    swa_cache = min(SWA_WINDOW, PAST_LEN)
    band_cache = min(BAND_BACK * CHUNK, PAST_LEN)
    F2 = 2 * D_FF
    D = D_MODEL
    return {
        "x_prompt": nrm((BATCH, SEQ, D), 1.0),
        "x_sample": nrm((DEC_BATCH, DEC_SEQ, D), 1.0),
        "mem_prompt": nrm((BATCH, MEM_LEN, D), 1.0),
        "cache_swa_k": nrm((DEPTH, DEC_BATCH, swa_cache, SWA_KV_HEADS, HEAD_DIM), 1.0),
        "cache_swa_v": nrm((DEPTH, DEC_BATCH, swa_cache, SWA_KV_HEADS, HEAD_DIM), 1.0),
        "state_ret": nrm((DEPTH, DEC_BATCH, RET_HEADS, RET_DK, RET_DV), 0.5),
        "cache_band_k": nrm((DEPTH, DEC_BATCH, band_cache, BAND_HEADS, HEAD_DIM), 1.0),
        "cache_band_v": nrm((DEPTH, DEC_BATCH, band_cache, BAND_HEADS, HEAD_DIM), 1.0),
        "state_ffn_conv": nrm((DEPTH, DEC_BATCH, CONV_W - 1, F2), 1.0),
        "cache_mem_k": nrm((DEPTH, DEC_BATCH, MEM_LEN, MEM_HEADS, MEM_HD), 1.0),
        "cache_mem_v": nrm((DEPTH, DEC_BATCH, MEM_LEN, MEM_HEADS, MEM_HD), 1.0),
        "w_in": nrm((DEPTH, D, IN_COLS), D ** -0.5),
        "t5_table": nrm((T5_BUCKETS, SWA_HEADS), 0.2),
        "swa_sink": nrm((DEPTH, SWA_HEADS), 0.5),
        "band_rel_table": nrm((DEPTH, BAND_HEADS, 2 * BAND_MAX_REL + 1), 0.2),
        "w_br_a": nrm((DEPTH, SWA_Q_W, D), SWA_Q_W ** -0.5),
        "w_br_b": nrm((DEPTH, RET_V_W, D), RET_V_W ** -0.5),
        "w_br_c": nrm((DEPTH, BAND_W, D), BAND_W ** -0.5),
        "w_mix_o": nrm((DEPTH, D, D), D ** -0.5 * DN_BETA),
        "ln1_g": 1.0 + nrm((DEPTH, D), 0.01),
        "ln1_b": nrm((DEPTH, D), 0.01),
        "w_mq": nrm((DEPTH, D, MEM_W), D ** -0.5),
        "w_mk": nrm((DEPTH, D, MEM_W), D ** -0.5),
        "w_mv": nrm((DEPTH, D, MEM_W), D ** -0.5),
        "w_mo": nrm((DEPTH, MEM_W, D), MEM_W ** -0.5 * DN_BETA),
        "ln2_g": 1.0 + nrm((DEPTH, D), 0.01),
        "ln2_b": nrm((DEPTH, D), 0.01),
        "w_ffn_in": nrm((DEPTH, D, F2), D ** -0.5),
        "ffn_conv_w": nrm((DEPTH, CONV_W, F2), CONV_W ** -0.5),
        "ffn_conv_b": nrm((DEPTH, F2), 0.01),
        "w_ffn_out": nrm((DEPTH, D_FF, D), D_FF ** -0.5 * DN_BETA),
        "ln3_g": 1.0 + nrm((DEPTH, D), 0.01),
        "ln3_b": nrm((DEPTH, D), 0.01),
    }


def reference(x_prompt, x_sample, mem_prompt, cache_swa_k, cache_swa_v, state_ret, cache_band_k,
              cache_band_v, state_ffn_conv, cache_mem_k, cache_mem_v, w_in, t5_table, swa_sink,
              band_rel_table, w_br_a, w_br_b, w_br_c, w_mix_o, ln1_g, ln1_b, w_mq, w_mk, w_mv, w_mo,
              ln2_g, ln2_b, w_ffn_in, ffn_conv_w, ffn_conv_b, w_ffn_out, ln3_g, ln3_b):
    xp = x_prompt
    xs = x_sample
    Bp = xp.shape[0]
    p_ak, p_av, p_rs, p_bk, p_bv, p_fc, p_mk, p_mv = [], [], [], [], [], [], [], []
    s_ak, s_av, s_rs, s_bk, s_bv, s_fc = [], [], [], [], [], []
    for l in range(DEPTH):
        mix, (ak, av, rs, bk, bv) = mixer_prompt(xp, w_in[l], t5_table, swa_sink[l], band_rel_table[l],
                                                 w_br_a[l], w_br_b[l], w_br_c[l], w_mix_o[l])
        xp = layer_norm(DN_ALPHA * xp + mix, ln1_g[l], ln1_b[l])
        mk, mv = mem_kv(mem_prompt, w_mk[l], w_mv[l])
        xp = layer_norm(DN_ALPHA * xp + mem_attend(xp, mk, mv, w_mq[l], w_mo[l]), ln2_g[l], ln2_b[l])
        f, fc = conv_ffn(xp, jnp.zeros((Bp, CONV_W - 1, 2 * D_FF), xp.dtype), w_ffn_in[l],
                         ffn_conv_w[l], ffn_conv_b[l], w_ffn_out[l])
        xp = layer_norm(DN_ALPHA * xp + f, ln3_g[l], ln3_b[l])
        p_ak.append(ak); p_av.append(av); p_rs.append(rs); p_bk.append(bk); p_bv.append(bv)
        p_fc.append(fc); p_mk.append(mk); p_mv.append(mv)
        mix, (ak, av, rs, bk, bv) = mixer_sample(xs, cache_swa_k[l], cache_swa_v[l], state_ret[l],
                                                 cache_band_k[l], cache_band_v[l], w_in[l], t5_table,
                                                 swa_sink[l], band_rel_table[l], w_br_a[l], w_br_b[l],
                                                 w_br_c[l], w_mix_o[l])
        xs = layer_norm(DN_ALPHA * xs + mix, ln1_g[l], ln1_b[l])
        xs = layer_norm(DN_ALPHA * xs + mem_attend(xs, cache_mem_k[l], cache_mem_v[l], w_mq[l], w_mo[l]),
                        ln2_g[l], ln2_b[l])
        f, fc = conv_ffn(xs, state_ffn_conv[l], w_ffn_in[l], ffn_conv_w[l], ffn_conv_b[l], w_ffn_out[l])
        xs = layer_norm(DN_ALPHA * xs + f, ln3_g[l], ln3_b[l])
        s_ak.append(ak); s_av.append(av); s_rs.append(rs); s_bk.append(bk); s_bv.append(bv)
        s_fc.append(fc)
    st = lambda a: jnp.stack(a, 0)
    return (xp, xs,
            st(p_ak), st(p_av), st(p_rs), st(p_bk), st(p_bv), st(p_fc), st(p_mk), st(p_mv),
            st(s_ak), st(s_av), st(s_rs), st(s_bk), st(s_bv), st(s_fc))
```

```cpp
#include <hip/hip_runtime.h>
#include <cstdio>
#include <cstdint>

#define LAS __attribute__((address_space(3)))
#define GAS __attribute__((address_space(1)))
typedef unsigned short bf16_t;
typedef short bf16x8 __attribute__((ext_vector_type(8)));
typedef short s16x4 __attribute__((ext_vector_type(4)));
typedef float f32x4 __attribute__((ext_vector_type(4)));
typedef float f32x2 __attribute__((ext_vector_type(2)));
typedef float f32x16 __attribute__((ext_vector_type(16)));
typedef unsigned u32x4 __attribute__((ext_vector_type(4)));
typedef unsigned u32x2 __attribute__((ext_vector_type(2)));
typedef __bf16 bf16x2_t __attribute__((ext_vector_type(2)));

#ifndef N_LAUNCH_MODE
#define N_LAUNCH_MODE 0
#endif

constexpr int DM = 2048, SEQ = 4096, MP = 8192, MS = 256, MA = 8448;
constexpr int NIN = 13568, FF = 5632, FF2 = 11264;
constexpr int C_QA = 0, C_KA = 1024, C_VA = 1152, C_QB = 1280, C_KB = 1792, C_VB = 2304, C_GR = 3328, C_QC = 4352, C_KC = 5376, C_VC = 6400, C_GA = 7424, C_GB = 9472, C_GC = 11520;
constexpr float LN_EPS = 1e-5f, RET_EPS = 1e-5f;
constexpr float LOG2E = 1.4426950408889634f;
constexpr float DN_ALPHA = 1.4142135623730951f;

constexpr size_t O_Y = 0, O_YS = 16777216, O_SWAKP = 17301504, O_SWAVP = 17367040, O_RETP = 17432576, O_BKP = 17694720, O_BVP = 19791872,
                 O_FCP = 21889024, O_MKP = 21979136, O_MVP = 24076288, O_SWAKS = 26173440, O_SWAVS = 26238976, O_RETS = 26304512,
                 O_BKS = 28401664, O_BVS = 28925952, O_FCS = 29450240, O_END = 30171136;

constexpr size_t MiB = 1u << 20;
constexpr size_t WS_CTL = 0, CTL_ZERO_BYTES = 64 * 1024;
constexpr size_t WS_ROPE = 1 * MiB;
constexpr size_t WS_LUT = 2 * MiB;
constexpr size_t WS_MEMB = 3 * MiB;
constexpr size_t WS_MKB = 5 * MiB;
constexpr size_t WS_MVB = 9 * MiB;
constexpr size_t WS_MBT = 13 * MiB;
constexpr size_t WS_NBT = 29 * MiB;
constexpr size_t WS_QM = 45 * MiB;
constexpr size_t WS_OM = 46 * MiB;
constexpr size_t WS_PM = 47 * MiB;
constexpr size_t WS_XB = 63 * MiB;
constexpr size_t WS_X = 96 * MiB;
constexpr size_t WS_W = 162 * MiB;
constexpr size_t W_IN = WS_W;
constexpr size_t W_BR = W_IN + 2 * 53 * MiB;
constexpr size_t W_MIXO = W_BR + 2 * 12 * MiB;
constexpr size_t W_MQN = W_MIXO + 16 * MiB;
constexpr size_t W_MQT = W_MQN + 16 * MiB;
constexpr size_t W_MKT = W_MQT + 16 * MiB;
constexpr size_t W_MVT = W_MKT + 16 * MiB;
constexpr size_t W_MOT = W_MVT + 16 * MiB;
constexpr size_t W_FIN = W_MOT + 16 * MiB;
constexpr size_t W_FOUT = W_FIN + 2 * 44 * MiB;
constexpr size_t WS_R1 = W_FOUT + 2 * 22 * MiB;
constexpr size_t WS_R2 = WS_R1 + 219 * MiB;
constexpr size_t WS_OB = WS_R2;
constexpr size_t WS_TMP = WS_R2 + 50 * MiB;
constexpr size_t WS_MIX = WS_TMP + 66 * MiB;
constexpr size_t WS_H = WS_R2;
constexpr size_t WS_UPD = WS_TMP;
constexpr size_t WS_S0T = WS_TMP + 64 * MiB;
constexpr size_t WS_END = WS_MIX + 33 * MiB;
static_assert(WS_R1 == 520 * MiB, "ws map");
static_assert(WS_S0T + 32 * MiB <= WS_END, "ws map");
static_assert(WS_END <= 1000 * MiB, "ws map");

constexpr int RING_BYTES = 131072;
constexpr int SMTAB_OFF = RING_BYTES;
constexpr int MISC_OFF = 147456;
constexpr int LDS_BYTES = 148480;
constexpr int WREG = 18432;
constexpr int AT_VT = 9216;
constexpr int AT_LUTC = 8 * AT_VT;
constexpr int AT_LUTA = AT_LUTC + 16 * 640 * 4;
static_assert(AT_LUTA + 16 * 256 * 4 <= RING_BYTES, "lds map");

__device__ __forceinline__ float bf2f(unsigned short b) { return __uint_as_float((unsigned)b << 16); }
__device__ __forceinline__ unsigned pk2(float lo, float hi) { f32x2 v = {lo, hi}; bf16x2_t b = __builtin_convertvector(v, bf16x2_t); return __builtin_bit_cast(unsigned, b); }
__device__ __forceinline__ unsigned short f2bf(float f) { return (unsigned short)(pk2(f, 0.f) & 0xffffu); }
__device__ __forceinline__ void unpack8(const u32x4 w, float (&f)[8]) {
#pragma unroll
    for (int i = 0; i < 4; ++i) { f[2 * i] = __uint_as_float(w[i] << 16); f[2 * i + 1] = __uint_as_float(w[i] & 0xffff0000u); }
}
__device__ __forceinline__ u32x4 pack8(const float (&f)[8]) { u32x4 w; w.x = pk2(f[0], f[1]); w.y = pk2(f[2], f[3]); w.z = pk2(f[4], f[5]); w.w = pk2(f[6], f[7]); return w; }
__device__ __forceinline__ float ex2(float x) { return __builtin_amdgcn_exp2f(x); }
__device__ __forceinline__ float rcp(float x) { return __builtin_amdgcn_rcpf(x); }
__device__ __forceinline__ float sigmoidf_(float g) { return rcp(1.f + ex2(-g * LOG2E)); }
__device__ __forceinline__ float wave_sum(float v) {
#pragma unroll
    for (int o = 1; o < 64; o <<= 1) v += __shfl_xor(v, o);
    return v;
}
__device__ __forceinline__ float wave_max(float v) {
#pragma unroll
    for (int o = 1; o < 64; o <<= 1) v = fmaxf(v, __shfl_xor(v, o));
    return v;
}
#define LDS_WAIT() asm volatile("s_waitcnt lgkmcnt(0)" ::: "memory")
#define VM_WAIT() asm volatile("s_waitcnt vmcnt(0)" ::: "memory")

__device__ __forceinline__ float gelu_erf(float v) {
    const float av = fabsf(v), t = rcp(av * 0.2316418882f + 1.0f);
    float q = t * 0.5307027145f + (-0.7265760135f); q = q * t + 0.7107068705f; q = q * t + (-0.142248368f); q = q * t + 0.127414796f; q = q * t;
    const float e = ex2((v * v) * (-0.72134752044f));
    const float m = v * (q * e);
    return v < 0.f ? m : v - m;
}

namespace pg8 {
constexpr int BM = 256, BK = 64, HALF = 128, HTB = HALF * BK * 2, STAGE_BYTES = 8 * HTB, NXCD = 8, WGM = 8;
__host__ __device__ __forceinline__ int lds_byte(int r, int c) { const int st = (r >> 4) * 2 + (c >> 5), rr = r & 15, cc = c & 31, ob = rr * 64 + cc * 2; return st * 1024 + (ob ^ (((ob >> 9) & 1) << 5)); }
__host__ __device__ __forceinline__ void stage_rc(int b, int& R, int& C) { const int st = b / 1024, sb = b % 1024, swz = sb ^ (((sb >> 9) & 1) << 5); R = (st >> 1) * 16 + swz / 64; C = (st & 1) * 32 + (swz % 64) / 2; }
__host__ __device__ __forceinline__ int perm32(int rho) { const int n = rho >> 4, i = rho & 15; return 8 * (i >> 2) + 4 * n + (i & 3); }

struct Unit { int pm, pn, z; };
struct Gemm { const bf16_t* A; const bf16_t* Bt; int lda, ldb, K; long zsA1, zsA0, zsB1, zsB0; int zshift; };

struct Order {
    int nM, nN, per, total, G, c;
    __device__ __forceinline__ void init(int nM_, int nN_, int nZ_, int G_, int c_) { nM = nM_; nN = nN_; per = nM_ * nN_; total = per * nZ_; G = G_; c = c_; }
    __device__ __forceinline__ bool next(int i, Unit& u) const {
        const long L = (long)i * G + c; if (L >= total) return false;
        int wgid = (int)L; { const int q = total / NXCD, r = total % NXCD, xcd = wgid % NXCD, off = wgid / NXCD; wgid = (xcd < r ? xcd * (q + 1) : r * (q + 1) + (xcd - r) * q) + off; }
        u.z = wgid / per; wgid -= u.z * per;
        const int nig = WGM * nN, gid = wgid / nig, fm = gid * WGM, gsz = (nM - fm) < WGM ? (nM - fm) : WGM;
        u.pm = fm + ((wgid % nig) % gsz); u.pn = (wgid % nig) / gsz; return true;
    }
};

typedef f32x4 Acc[2][2][4][2];

struct EpiOut {
    static constexpr bool PERM = true;
    bf16_t* O; int ldo; long zsO1, zsO0; float* F; int ldf; long zsF; float scale; int zshift;
    __device__ __forceinline__ void operator()(Acc& acc, const Unit& u, int wr, int wc, int fr, int fq, int ui, LAS unsigned char* lds) const {
        const int zh = u.z >> zshift, zl = u.z & ((1 << zshift) - 1);
        const int row0 = u.pm * BM + wr * 64 + fr, col0 = u.pn * BM + wc * 32 + 8 * fq;
        bf16_t* ob = O ? O + zh * zsO1 + zl * zsO0 : nullptr; float* fb = F ? F + (long)u.z * zsF : nullptr;
#pragma unroll
        for (int ai = 0; ai < 2; ++ai)
#pragma unroll
            for (int m = 0; m < 4; ++m) { const size_t row = (size_t)(row0 + ai * HALF + m * 16);
#pragma unroll
                for (int bj = 0; bj < 2; ++bj) { const f32x4 v0 = acc[ai][bj][m][0] * scale, v1 = acc[ai][bj][m][1] * scale; const int col = col0 + bj * HALF;
                    if (ob) { u32x4 w; w.x = pk2(v0[0], v0[1]); w.y = pk2(v0[2], v0[3]); w.z = pk2(v1[0], v1[1]); w.w = pk2(v1[2], v1[3]); *(u32x4*)(ob + row * ldo + col) = w; }
                    if (fb) { *(f32x4*)(fb + row * ldf + col) = v0; *(f32x4*)(fb + row * ldf + col + 4) = v1; } } }
    }
};
template <int STEP> struct EpiGate {
    static constexpr bool PERM = true;
    const bf16_t* Gt; int ldg, gcol; float* T; bf16_t* MIX;
    __device__ __forceinline__ void operator()(Acc& acc, const Unit& u, int wr, int wc, int fr, int fq, int ui, LAS unsigned char* lds) const {
        const int row0 = u.pm * BM + wr * 64 + fr, col0 = u.pn * BM + wc * 32 + 8 * fq;
#pragma unroll
        for (int ai = 0; ai < 2; ++ai)
#pragma unroll
            for (int m = 0; m < 4; ++m) { const size_t row = (size_t)(row0 + ai * HALF + m * 16);
#pragma unroll
                for (int bj = 0; bj < 2; ++bj) { const int col = col0 + bj * HALF;
                    const u32x4 gw = *(const u32x4*)(Gt + row * ldg + gcol + col); float g[8]; unpack8(gw, g);
                    float v[8];
#pragma unroll
                    for (int e = 0; e < 4; ++e) { v[e] = acc[ai][bj][m][0][e] * sigmoidf_(g[e]); v[4 + e] = acc[ai][bj][m][1][e] * sigmoidf_(g[4 + e]); }
                    float* tp = T + row * DM + col;
                    if (STEP > 0) { const f32x4 t0 = *(const f32x4*)tp, t1 = *(const f32x4*)(tp + 4);
#pragma unroll
                        for (int e = 0; e < 4; ++e) { v[e] += t0[e]; v[4 + e] += t1[e]; } }
                    if (STEP < 2) { *(f32x4*)tp = (f32x4){v[0], v[1], v[2], v[3]}; *(f32x4*)(tp + 4) = (f32x4){v[4], v[5], v[6], v[7]}; }
                    else *(u32x4*)(MIX + row * DM + col) = pack8(v); }
                asm volatile("" ::: "memory"); }
    }
};
struct EpiResid {
    static constexpr bool PERM = false;
    const float* src0; const float* src1; float* dst; long zrows;
    __device__ __forceinline__ void operator()(Acc& acc, const Unit& u, int wr, int wc, int fr, int fq, int ui, LAS unsigned char* lds) const {
        const int col0 = u.pn * BM + wc * 32 + 4 * fq; const long rbase = (long)u.z * zrows + u.pm * BM + wr * 64 + fr;
        const float* sb = (rbase >= MP && src1) ? src1 - (size_t)MP * DM : src0;
#pragma unroll
        for (int ai = 0; ai < 2; ++ai)
#pragma unroll
            for (int m = 0; m < 4; ++m) { const size_t off = (size_t)(rbase + ai * HALF + m * 16) * DM + col0;
#pragma unroll
                for (int bj = 0; bj < 2; ++bj)
#pragma unroll
                    for (int n = 0; n < 2; ++n) { const f32x4 s = *(const f32x4*)(sb + off + bj * HALF + n * 16); *(f32x4*)(dst + off + bj * HALF + n * 16) = s * DN_ALPHA + acc[ai][bj][m][n]; } }
    }
};
struct EpiSoftmax {
    static constexpr bool PERM = true;
    bf16_t* O; int ldo; long zsO;
    __device__ __forceinline__ void operator()(Acc& acc, const Unit& u, int wr, int wc, int fr, int fq, int ui, LAS unsigned char* lds) const {
        LAS f32x2* tab = (LAS f32x2*)(lds + SMTAB_OFF + (ui & 1) * 8192);
        float mloc[2][4];
#pragma unroll
        for (int ai = 0; ai < 2; ++ai)
#pragma unroll
            for (int m = 0; m < 4; ++m) {
                float mx = -INFINITY;
#pragma unroll
                for (int bj = 0; bj < 2; ++bj)
#pragma unroll
                    for (int n = 0; n < 2; ++n) { const f32x4 x = acc[ai][bj][m][n]; mx = fmaxf(fmaxf(mx, fmaxf(x[0], x[1])), fmaxf(x[2], x[3])); }
                mx = fmaxf(mx, __shfl_xor(mx, 16)); mx = fmaxf(mx, __shfl_xor(mx, 32));
                float s = 0.f;
#pragma unroll
                for (int bj = 0; bj < 2; ++bj)
#pragma unroll
                    for (int n = 0; n < 2; ++n) { f32x4 x = acc[ai][bj][m][n]; x[0] = ex2(x[0] - mx); x[1] = ex2(x[1] - mx); x[2] = ex2(x[2] - mx); x[3] = ex2(x[3] - mx); acc[ai][bj][m][n] = x; s += (x[0] + x[1]) + (x[2] + x[3]); }
                s += __shfl_xor(s, 16); s += __shfl_xor(s, 32);
                mloc[ai][m] = mx;
                if (fq == 0) tab[(ai * HALF + wr * 64 + m * 16 + fr) * 4 + wc] = (f32x2){mx, s};
                asm volatile("" ::: "memory");
            }
        asm volatile("s_waitcnt lgkmcnt(0)" ::: "memory"); __builtin_amdgcn_s_barrier(); asm volatile("" ::: "memory");
        const int row0 = u.pm * BM + wr * 64 + fr, col0 = u.pn * BM + wc * 32 + 8 * fq;
        bf16_t* ob = O + (long)u.z * zsO;
#pragma unroll
        for (int ai = 0; ai < 2; ++ai)
#pragma unroll
            for (int m = 0; m < 4; ++m) { const int rl = ai * HALF + wr * 64 + m * 16 + fr;
                const f32x2 t0 = tab[rl * 4 + 0], t1 = tab[rl * 4 + 1], t2 = tab[rl * 4 + 2], t3 = tab[rl * 4 + 3];
                const float M = fmaxf(fmaxf(t0.x, t1.x), fmaxf(t2.x, t3.x));
                const float tot = t0.y * ex2(t0.x - M) + t1.y * ex2(t1.x - M) + t2.y * ex2(t2.x - M) + t3.y * ex2(t3.x - M);
                const float fac = ex2(mloc[ai][m] - M) / tot;
                const size_t row = (size_t)(row0 + ai * HALF + m * 16);
#pragma unroll
                for (int bj = 0; bj < 2; ++bj) { const f32x4 v0 = acc[ai][bj][m][0] * fac, v1 = acc[ai][bj][m][1] * fac;
                    u32x4 w; w.x = pk2(v0[0], v0[1]); w.y = pk2(v0[2], v0[3]); w.z = pk2(v1[0], v1[1]); w.w = pk2(v1[2], v1[3]);
                    *(u32x4*)(ob + row * ldo + col0 + bj * HALF) = w; }
                asm volatile("" ::: "memory"); }
    }
};

template <class Epi>
__device__ __forceinline__ void gemm_phase(LAS unsigned char* lds, const Gemm g, const Order& S, const Epi& E) {
    int tid = threadIdx.x; asm volatile("" : "+v"(tid));
    const int wid = __builtin_amdgcn_readfirstlane(tid >> 6), lane = tid & 63, wr = wid >> 2, wc = wid & 3, fr = lane & 15, fq = lane >> 4;
    const int K = g.K, nt = K / BK;
    unsigned voffA[2], voffB[2];
#pragma unroll
    for (int i = 0; i < 2; ++i) { int R, C; stage_rc(tid * 16 + i * 8192, R, C); const int Rb = Epi::PERM ? ((R & ~31) + perm32(R & 31)) : R;
        voffA[i] = (unsigned)(R * g.lda + C) * 2u; voffB[i] = (unsigned)(Rb * g.ldb + C) * 2u; }
    const size_t kstep = (size_t)(BK * 2);
    const size_t hstepA = (size_t)HALF * g.lda * 2, hstepB = (size_t)HALF * g.ldb * 2;
    const size_t tstepA = 2 * hstepA, tstepB = 2 * hstepB;
    const int zmask = (1 << g.zshift) - 1;
    const unsigned ldsw = (unsigned)wid * 1024u;
    const int aoff = lds_byte(wr * 64 + fr, fq * 8), boff = lds_byte(wc * 32 + fr, fq * 8);
#define PG8_SA(b, h) (((b) * 2 + (h)) * HTB)
#define PG8_SB(b, h) ((4 + (b) * 2 + (h)) * HTB)
#define PG8_STAGE(bufoff, gbase, voff) do { _Pragma("unroll") for (int _i = 0; _i < 2; ++_i) \
        __builtin_amdgcn_global_load_lds((const unsigned*)((const char*)(gbase) + (voff)[_i]), (LAS unsigned*)(lds + (bufoff) + ldsw + _i * 8192), 16, 0, 0); } while (0)
#define PG8_LDA(dst, b, h) do { _Pragma("unroll") for (int m = 0; m < 4; ++m) _Pragma("unroll") for (int k = 0; k < 2; ++k) dst[m][k] = *(const LAS bf16x8*)(lds + PG8_SA(b, h) + aoff + m * 2048 + k * 1024); } while (0)
#define PG8_LDB(dst, b, h) do { _Pragma("unroll") for (int n = 0; n < 2; ++n) _Pragma("unroll") for (int k = 0; k < 2; ++k) dst[n][k] = *(const LAS bf16x8*)(lds + PG8_SB(b, h) + boff + n * 2048 + k * 1024); } while (0)
#define PG8_MMA(ai, bj, At, Bt) do { __builtin_amdgcn_s_setprio(1); _Pragma("unroll") for (int m = 0; m < 4; ++m) _Pragma("unroll") for (int n = 0; n < 2; ++n) _Pragma("unroll") for (int k = 0; k < 2; ++k) \
        acc[ai][bj][m][n] = __builtin_amdgcn_mfma_f32_16x16x32_bf16(Bt[n][k], At[m][k], acc[ai][bj][m][n], 0, 0, 0); __builtin_amdgcn_s_setprio(0); } while (0)
#define PG8_WAIT_V(n) asm volatile("s_waitcnt vmcnt(" #n ")" ::: "memory")
#define PG8_WAIT_L(n) asm volatile("s_waitcnt lgkmcnt(" #n ")" ::: "memory")
#define PG8_BAR __builtin_amdgcn_s_barrier()
#define PG8_SCHED __builtin_amdgcn_sched_barrier(0)
#define PG8_ABASE(u) ((const char*)g.A + ((size_t)((u).z >> g.zshift) * g.zsA1 + (size_t)((u).z & zmask) * g.zsA0) * 2 + (size_t)(u).pm * tstepA)
#define PG8_BBASE(u) ((const char*)g.Bt + ((size_t)((u).z >> g.zshift) * g.zsB1 + (size_t)((u).z & zmask) * g.zsB0) * 2 + (size_t)(u).pn * tstepB)
    Unit cur, nxt; int ui = 0;
    if (!S.next(0, cur)) return;
    Acc acc;
#pragma unroll
    for (int a = 0; a < 2; ++a)
#pragma unroll
        for (int b = 0; b < 2; ++b)
#pragma unroll
            for (int m = 0; m < 4; ++m)
#pragma unroll
                for (int n = 0; n < 2; ++n) acc[a][b][m][n] = (f32x4){0.f, 0.f, 0.f, 0.f};
    bf16x8 At[4][2], B0[2][2], B1[2][2];
    const char* cA = PG8_ABASE(cur); const char* cB = PG8_BBASE(cur);
    PG8_STAGE(PG8_SB(0, 0), cB, voffB); PG8_STAGE(PG8_SB(0, 1), cB + hstepB, voffB); PG8_STAGE(PG8_SA(0, 0), cA, voffA); PG8_STAGE(PG8_SA(0, 1), cA + hstepA, voffA);
    if (wr == 1) PG8_BAR;
    PG8_WAIT_V(2); PG8_BAR;
    PG8_STAGE(PG8_SB(1, 0), cB + kstep, voffB); PG8_STAGE(PG8_SA(1, 0), cA + kstep, voffA); PG8_STAGE(PG8_SB(1, 1), cB + hstepB + kstep, voffB);
    PG8_WAIT_V(6); PG8_BAR;
    for (;;) {
        const bool has_next = S.next(ui + 1, nxt);
        const char* nA = has_next ? PG8_ABASE(nxt) : cA; const char* nB = has_next ? PG8_BBASE(nxt) : cB;
        for (int t = 0; t < nt; t += 2) {
            const bool last = (t == nt - 2);
            const char* a1 = cA + (size_t)(t + 1) * kstep;
            const char* a2 = last ? nA : cA + (size_t)(t + 2) * kstep; const char* b2 = last ? nB : cB + (size_t)(t + 2) * kstep;
            const char* a3 = a2 + kstep; const char* b3 = b2 + kstep;
            PG8_LDB(B0, 0, 0); PG8_LDB(B1, 0, 1); PG8_SCHED; PG8_LDA(At, 0, 0); PG8_STAGE(PG8_SA(1, 1), a1 + hstepA, voffA);
            PG8_WAIT_V(8); PG8_WAIT_L(0); PG8_BAR; PG8_MMA(0, 0, At, B0); PG8_MMA(0, 1, At, B1); PG8_BAR; PG8_SCHED;
            PG8_LDA(At, 0, 1); PG8_STAGE(PG8_SB(0, 0), b2, voffB); PG8_STAGE(PG8_SB(0, 1), b2 + hstepB, voffB); PG8_STAGE(PG8_SA(0, 0), a2, voffA);
            PG8_WAIT_V(8); PG8_WAIT_L(0); PG8_BAR; PG8_MMA(1, 0, At, B0); PG8_MMA(1, 1, At, B1); PG8_BAR; PG8_SCHED;
            PG8_LDB(B0, 1, 0); PG8_LDB(B1, 1, 1); PG8_SCHED; PG8_LDA(At, 1, 0); PG8_STAGE(PG8_SA(0, 1), a2 + hstepA, voffA);
            PG8_WAIT_V(8); PG8_WAIT_L(0); PG8_BAR; PG8_MMA(0, 0, At, B0); PG8_MMA(0, 1, At, B1); PG8_BAR; PG8_SCHED;
            PG8_LDA(At, 1, 1); PG8_STAGE(PG8_SB(1, 0), b3, voffB); PG8_STAGE(PG8_SB(1, 1), b3 + hstepB, voffB); PG8_STAGE(PG8_SA(1, 0), a3, voffA);
            PG8_WAIT_V(8); PG8_WAIT_L(0); PG8_BAR; PG8_MMA(1, 0, At, B0); PG8_MMA(1, 1, At, B1); PG8_BAR; PG8_SCHED;
        }
        if (wr == 0) PG8_BAR;
        E(acc, cur, wr, wc, fr, fq, ui, lds);
        if (!has_next) break;
#pragma unroll
        for (int a = 0; a < 2; ++a)
#pragma unroll
            for (int b = 0; b < 2; ++b)
#pragma unroll
                for (int m = 0; m < 4; ++m)
#pragma unroll
                    for (int n = 0; n < 2; ++n) acc[a][b][m][n] = (f32x4){0.f, 0.f, 0.f, 0.f};
        cur = nxt; cA = nA; cB = nB; ++ui;
        if (wr == 1) PG8_BAR;
    }
    PG8_WAIT_V(0);
    PG8_BAR;
#undef PG8_SA
#undef PG8_SB
#undef PG8_STAGE
#undef PG8_LDA
#undef PG8_LDB
#undef PG8_MMA
#undef PG8_WAIT_V
#undef PG8_WAIT_L
#undef PG8_BAR
#undef PG8_SCHED
#undef PG8_ABASE
#undef PG8_BBASE
}
}

#define XB_TMO      128
#define XB_XCNT(j)  (256  + 64 * (j))
#define XB_XSUB(j)  (1280 + 64 * (j))
#define XB_XGEN(j)  (2304 + 64 * (j))
#define XB_TOP      3328
#define XB_TOPGEN   3392
#define XCD_BAR_WORDS 3456
#define XB_SPIN_CAP (1u << 18)
__device__ __forceinline__ unsigned xb_ld(unsigned* p)              { return __hip_atomic_load(p, __ATOMIC_RELAXED, __HIP_MEMORY_SCOPE_AGENT); }
__device__ __forceinline__ unsigned xb_add(unsigned* p, unsigned v) { return __hip_atomic_fetch_add(p, v, __ATOMIC_RELAXED, __HIP_MEMORY_SCOPE_AGENT); }
__device__ __forceinline__ unsigned xb_xcc_id() { return (unsigned)__builtin_amdgcn_s_getreg((3 << 11) | 20) & 0xFu; }
#define XB_SPIN(cond, bar) do { unsigned _sp = 0; while (cond) { __builtin_amdgcn_s_sleep(1); \
    if ((++_sp & 255u) == 0u) { if (xb_ld(&(bar)[XB_TMO])) break; if (_sp > XB_SPIN_CAP) { atomicAdd(&(bar)[XB_TMO], 1u); break; } } } } while (0)
struct XcdBarrier { unsigned* bar; unsigned x; volatile LAS unsigned* st; };
__device__ __forceinline__ XcdBarrier xcd_barrier_post(unsigned* bar, volatile LAS unsigned* st) {
    XcdBarrier b; b.bar = bar; b.x = xb_xcc_id(); b.st = st;
    if (threadIdx.x == 0) (void)xb_add(&bar[XB_XCNT(b.x)], 1u);
    return b;
}
__device__ __forceinline__ void xcd_barrier_complete(unsigned* bar, unsigned x, unsigned& nloc, unsigned& nx) {
    const unsigned G = gridDim.x * gridDim.y * gridDim.z;
    unsigned sum, cnt, mine, sp = 0u;
    for (;;) {
        sum = 0u; cnt = 0u; mine = 0u;
#pragma unroll
        for (unsigned j = 0; j < 16; ++j) { const unsigned c = xb_ld(&bar[XB_XCNT(j)]); sum += c; cnt += (c > 0u) ? 1u : 0u; mine = (j == x) ? c : mine; }
        if (sum == G) break;
        __builtin_amdgcn_s_sleep(1);
        if ((++sp & 255u) == 0u) { if (xb_ld(&bar[XB_TMO])) break; if (sp > XB_SPIN_CAP) { atomicAdd(&bar[XB_TMO], 1u); break; } }
    }
    nloc = mine > 0u ? mine : 1u; nx = cnt > 0u ? cnt : 1u;
}
__device__ __forceinline__ void xcd_barrier(const XcdBarrier& b) {
    asm volatile("s_waitcnt vmcnt(0)" ::: "memory");
    __syncthreads();
    if (threadIdx.x == 0) {
        unsigned* bar = b.bar;
        __builtin_amdgcn_s_waitcnt(0);
        unsigned nloc = b.st[0], nx = b.st[1];
        if (nloc == 0u) { xcd_barrier_complete(bar, b.x, nloc, nx); b.st[0] = nloc; b.st[1] = nx; }
        const unsigned old = xb_add(&bar[XB_XSUB(b.x)], 1u);
        const unsigned gen = old / nloc;
        if (old + 1u == (gen + 1u) * nloc) {
            __builtin_amdgcn_fence(__ATOMIC_RELEASE, "agent");
            asm volatile("s_waitcnt vmcnt(0)" ::: "memory");
            const unsigned og = xb_add(&bar[XB_TOP], 1u);
            const unsigned tg = og / nx;
            if (og + 1u == (tg + 1u) * nx) xb_add(&bar[XB_TOPGEN], 1u);
            else XB_SPIN(xb_ld(&bar[XB_TOPGEN]) == tg, bar);
            __builtin_amdgcn_fence(__ATOMIC_ACQUIRE, "agent");
            xb_add(&bar[XB_XGEN(b.x)], 1u);
            asm volatile("s_waitcnt vmcnt(0)" ::: "memory");
        } else {
            XB_SPIN(xb_ld(&bar[XB_XGEN(b.x)]) == gen, bar);
            __builtin_amdgcn_fence(__ATOMIC_ACQUIRE, "agent");
            asm volatile("s_waitcnt vmcnt(0)" ::: "memory");
        }
    }
    __syncthreads();
}

__device__ __forceinline__ void transpose_item(const float* W, int N, bf16_t* WT, int ldw, int koff, LAS float* scr, int item, int lane) {
    const int nblk = N / 32, kb = item / nblk, nb = item % nblk, k0 = 64 * kb, n0 = 32 * nb;
#pragma unroll 8
    for (int i = 0; i < 32; ++i) { const int kk = 2 * i + (lane >> 5); scr[kk * 33 + (lane & 31)] = W[(size_t)(k0 + kk) * N + n0 + (lane & 31)]; }
    LDS_WAIT(); asm volatile("" ::: "memory");
    const int c = lane & 7;
#pragma unroll
    for (int j = 0; j < 4; ++j) { const int n = (lane >> 3) + 8 * j; const LAS float* s = scr + (8 * c) * 33 + n;
        u32x4 o; o.x = pk2(s[0 * 33], s[1 * 33]); o.y = pk2(s[2 * 33], s[3 * 33]); o.z = pk2(s[4 * 33], s[5 * 33]); o.w = pk2(s[6 * 33], s[7 * 33]);
        *(u32x4*)(WT + (size_t)(n0 + n) * ldw + koff + k0 + 8 * c) = o; }
    LDS_WAIT(); asm volatile("" ::: "memory");
}
__device__ __forceinline__ void cvt_plain(const float* src, bf16_t* dst, size_t n8, int gtid, int gthreads) {
    for (size_t i = gtid; i < n8; i += gthreads) { const f32x4 a = *(const f32x4*)(src + i * 8), b = *(const f32x4*)(src + i * 8 + 4);
        u32x4 w; w.x = pk2(a[0], a[1]); w.y = pk2(a[2], a[3]); w.z = pk2(b[0], b[1]); w.w = pk2(b[2], b[3]); *(u32x4*)(dst + i * 8) = w; }
}
__device__ __forceinline__ int t5_bucket(int rel) {
    const int n = rel < 0 ? -rel : rel; int b;
    if (n < 8) b = n; else if (n < 12) b = 8; else if (n < 16) b = 9; else if (n < 23) b = 10; else if (n < 32) b = 11; else if (n < 46) b = 12; else if (n < 64) b = 13; else if (n < 91) b = 14; else b = 15;
    return (rel > 0 ? 16 : 0) + b;
}

typedef short v4i16_t __attribute__((ext_vector_type(4)));
__device__ __forceinline__ s16x4 vtr(const LAS unsigned char* p) { return __builtin_bit_cast(s16x4, __builtin_amdgcn_ds_read_tr16_b64_v4i16((LAS v4i16_t*)p)); }
template <int PITCH, bool PERMUTED> __device__ __forceinline__ int tr_lane_off(int lane) {
    const int hi = lane >> 5, blk = (lane >> 4) & 1, q = (lane & 15) >> 2, p = lane & 3;
    return ((PERMUTED ? 4 * hi : 8 * hi) + q) * PITCH + (16 * blk + 4 * p) * 2;
}
template <int PITCH, bool PERMUTED> __device__ __forceinline__ bf16x8 tr_frag(const LAS unsigned char* tile_lane  , int row0, int col0) {
    const s16x4 a = vtr(tile_lane + row0 * PITCH + col0 * 2), b = vtr(tile_lane + (row0 + (PERMUTED ? 8 : 4)) * PITCH + col0 * 2);
    return (bf16x8){a[0], a[1], a[2], a[3], b[0], b[1], b[2], b[3]};
}
__device__ __forceinline__ int crow(int r) { return (r & 3) + 8 * (r >> 2); }
__device__ __forceinline__ bf16x8 pack_frag(const f32x16& p, int base) {
    u32x4 w; w.x = pk2(p[base], p[base + 1]); w.y = pk2(p[base + 2], p[base + 3]); w.z = pk2(p[base + 4], p[base + 5]); w.w = pk2(p[base + 6], p[base + 7]);
    return __builtin_bit_cast(bf16x8, w);
}
__device__ __forceinline__ bf16x8 ldg_frag_bf16(const bf16_t* p) { return __builtin_bit_cast(bf16x8, *(const u32x4*)p); }
__device__ __forceinline__ bf16x8 ldg_frag_f32(const float* p) { const f32x4 a = *(const f32x4*)p, b = *(const f32x4*)(p + 4);
    u32x4 w; w.x = pk2(a[0], a[1]); w.y = pk2(a[2], a[3]); w.z = pk2(b[0], b[1]); w.w = pk2(b[2], b[3]); return __builtin_bit_cast(bf16x8, w); }

struct AttnSrc { const void* k0; const void* v0; int pitch0; int f32src; int nt0; int kpos0; const bf16_t* k1; const bf16_t* v1; int pitch1; int nvalid1; int kpos1; };
template <bool SINK, bool F32SRC>
__device__ __forceinline__ void attn_item(const bf16_t* qrow, const LAS float* lut, int lutidx, float sink_l2, const AttnSrc& S,
                                          bf16_t* orow, bool ovalid, LAS unsigned char* vt, int lane) {
    constexpr int VP = 144;
    const int r32 = lane & 31, hi = lane >> 5;
    const float qscale = 0.125f * LOG2E;
    bf16x8 qf[4];
#pragma unroll
    for (int d0 = 0; d0 < 4; ++d0) { float f[8]; unpack8(*(const u32x4*)(qrow + 16 * d0 + 8 * hi), f);
#pragma unroll
        for (int e = 0; e < 8; ++e) f[e] *= qscale;
        qf[d0] = __builtin_bit_cast(bf16x8, pack8(f)); }
    f32x16 o0, o1;
#pragma unroll
    for (int r = 0; r < 16; ++r) { o0[r] = 0.f; o1[r] = 0.f; }
    float m = SINK ? sink_l2 : -1e30f, l = (SINK && hi == 0) ? 1.f : 0.f;
    const LAS unsigned char* vtl = vt + tr_lane_off<VP, true>(lane);
    const int nt = S.nt0 + (S.k1 ? 1 : 0);
    for (int t = 0; t < nt; ++t) {
        const bool part = t >= S.nt0;
        const int nvalid = part ? S.nvalid1 : 64, kpos = part ? S.kpos1 : S.kpos0 + 64 * t;
        const bool f32s = F32SRC && !part;
        const int pitch = part ? S.pitch1 : S.pitch0;
        const char* kb = part ? (const char*)S.k1 : (const char*)S.k0 + (size_t)t * 64 * pitch * (F32SRC ? 4 : 2);
        const char* vb = part ? (const char*)S.v1 : (const char*)S.v0 + (size_t)t * 64 * pitch * (F32SRC ? 4 : 2);
#pragma unroll
        for (int i = 0; i < 8; ++i) { int row = 8 * i + (lane >> 3); const int ch = lane & 7; const int rsrc = row < nvalid ? row : nvalid - 1;
            u32x4 w;
            if (f32s) w = __builtin_bit_cast(u32x4, ldg_frag_f32((const float*)vb + (size_t)rsrc * pitch + ch * 8));
            else w = *(const u32x4*)((const bf16_t*)vb + (size_t)rsrc * pitch + ch * 8);
            *(LAS u32x4*)(vt + row * VP + ch * 16) = w;
            if ((i & 3) == 3) asm volatile("" ::: "memory"); }
        f32x16 p0, p1;
#pragma unroll
        for (int r = 0; r < 16; ++r) { p0[r] = 0.f; p1[r] = 0.f; }
        const int ra = r32 < nvalid ? r32 : nvalid - 1, rb = (r32 + 32) < nvalid ? r32 + 32 : nvalid - 1;
#pragma unroll
        for (int d0 = 0; d0 < 4; ++d0) {
            bf16x8 ka, kc;
            if (f32s) { ka = ldg_frag_f32((const float*)kb + (size_t)ra * pitch + 16 * d0 + 8 * hi); kc = ldg_frag_f32((const float*)kb + (size_t)rb * pitch + 16 * d0 + 8 * hi); }
            else { ka = ldg_frag_bf16((const bf16_t*)kb + (size_t)ra * pitch + 16 * d0 + 8 * hi); kc = ldg_frag_bf16((const bf16_t*)kb + (size_t)rb * pitch + 16 * d0 + 8 * hi); }
            p0 = __builtin_amdgcn_mfma_f32_32x32x16_bf16(ka, qf[d0], p0, 0, 0, 0);
            p1 = __builtin_amdgcn_mfma_f32_32x32x16_bf16(kc, qf[d0], p1, 0, 0, 0);
        }
        const int li = lutidx + kpos;
#pragma unroll
        for (int r = 0; r < 16; ++r) { p0[r] += lut[li + crow(r)]; p1[r] += lut[li + 32 + crow(r)]; }
        if (part) {
#pragma unroll
            for (int r = 0; r < 16; ++r) { const int kv = crow(r) + 4 * hi; if (kv >= nvalid) p0[r] = -INFINITY; if (kv + 32 >= nvalid) p1[r] = -INFINITY; }
        }
        float mx = fmaxf(p0[0], p1[0]);
#pragma unroll
        for (int r = 1; r < 16; ++r) mx = fmaxf(mx, fmaxf(p0[r], p1[r]));
        mx = fmaxf(mx, __shfl_xor(mx, 32));
        const float mn = fmaxf(m, mx), f = ex2(m - mn);
        m = mn; l *= f;
        float rs = 0.f;
#pragma unroll
        for (int r = 0; r < 16; ++r) { o0[r] *= f; o1[r] *= f; p0[r] = ex2(p0[r] - m); p1[r] = ex2(p1[r] - m); rs += p0[r] + p1[r]; }
        l += rs;
#pragma unroll
        for (int s4 = 0; s4 < 4; ++s4) {
            const bf16x8 pf = (s4 < 2) ? pack_frag(p0, 8 * (s4 & 1)) : pack_frag(p1, 8 * (s4 & 1));
            const bf16x8 v0 = tr_frag<VP, true>(vtl, 16 * s4, 0), v1 = tr_frag<VP, true>(vtl, 16 * s4, 32);
            o0 = __builtin_amdgcn_mfma_f32_32x32x16_bf16(v0, pf, o0, 0, 0, 0);
            o1 = __builtin_amdgcn_mfma_f32_32x32x16_bf16(v1, pf, o1, 0, 0, 0);
        }
    }
    l += __shfl_xor(l, 32);
    const float inv = 1.f / l;
    if (ovalid) {
#pragma unroll
        for (int rg = 0; rg < 4; ++rg) {
            u32x2 w0, w1; w0.x = pk2(o0[4 * rg] * inv, o0[4 * rg + 1] * inv); w0.y = pk2(o0[4 * rg + 2] * inv, o0[4 * rg + 3] * inv);
            w1.x = pk2(o1[4 * rg] * inv, o1[4 * rg + 1] * inv); w1.y = pk2(o1[4 * rg + 2] * inv, o1[4 * rg + 3] * inv);
            *(u32x2*)(orow + 8 * rg + 4 * hi) = w0; *(u32x2*)(orow + 32 + 8 * rg + 4 * hi) = w1; }
    }
}

struct Args { const float* in[33]; float* out; unsigned char* ws; int ph_lo, ph_hi; };
constexpr int NPHASE = 31;

__global__ void __launch_bounds__(512, 2) enc_fwd(Args args) {
    extern __shared__ __attribute__((aligned(16))) unsigned char lds_raw[];
    LAS unsigned char* lds = (LAS unsigned char*)lds_raw;
    volatile LAS unsigned* MISC = (volatile LAS unsigned*)(lds + MISC_OFF);
    const int tid0 = threadIdx.x, wave = __builtin_amdgcn_readfirstlane(tid0 >> 6);
    const int G = gridDim.x, bx = blockIdx.x;
    const int vcu = (G % 8 == 0) ? (bx % 8) * (G / 8) + bx / 8 : bx;
    const int gw0 = vcu * 8 + wave, NGW = G * 8;
    const int gthreads = NGW * 64;
    unsigned char* ws = args.ws;
    float* dout = args.out;
    for (int u = tid0; u < (LDS_BYTES - MISC_OFF) / 4; u += 512) ((LAS unsigned*)(lds + MISC_OFF))[u] = 0u;
    __syncthreads();
    XcdBarrier bar; bar.bar = (unsigned*)(ws + WS_CTL) + 4096; bar.x = 0; bar.st = nullptr;
    if (N_LAUNCH_MODE == 0) bar = xcd_barrier_post((unsigned*)(ws + WS_CTL) + 4096, MISC + 8);
    const int lo = args.ph_lo, hi = args.ph_hi;
#ifndef PHASE_MASK
#define PHASE_MASK 0xFFFFu
#endif
#define PH_EN(j) (((PHASE_MASK) >> (j)) & 1u)
#define IN(k) (lo <= (k) && (k) < hi)
#define SEAM(k) do { if (IN(k) && IN((k) + 1)) xcd_barrier(bar); } while (0)

    bf16_t* const XB = (bf16_t*)(ws + WS_XB); float* const X = (float*)(ws + WS_X);
    bf16_t* const P = (bf16_t*)(ws + WS_R1); bf16_t* const U = (bf16_t*)(ws + WS_R1);
    bf16_t* const OB = (bf16_t*)(ws + WS_OB); float* const TMP = (float*)(ws + WS_TMP); bf16_t* const MIX = (bf16_t*)(ws + WS_MIX);
    bf16_t* const H = (bf16_t*)(ws + WS_H); float* const UPD = (float*)(ws + WS_UPD); bf16_t* const S0T = (bf16_t*)(ws + WS_S0T);
    bf16_t* const MEMB = (bf16_t*)(ws + WS_MEMB); bf16_t* const PM = (bf16_t*)(ws + WS_PM);
    bf16_t* const QM = (bf16_t*)(ws + WS_QM); bf16_t* const OM = (bf16_t*)(ws + WS_OM);
    const float* const ROPE = (const float*)(ws + WS_ROPE);
    float* const LUTA = (float*)(ws + WS_LUT); float* const LUTC = LUTA + 16 * 256;

    if (PH_EN(15) && IN(0)) { int tid = threadIdx.x; asm volatile("" : "+v"(tid)); int gw = gw0; asm volatile("" : "+s"(gw)); const int lane = tid & 63; const int gtid = gw * 64 + lane; (void)gtid; (void)lane;
        LAS float* scr = (LAS float*)(lds + wave * 16384);
        constexpr int I_IN = 32 * 424, I_BR = 16 * 64, I_SQ = 32 * 64, I_FIN = 32 * 352, I_FOUT = 88 * 64;
        constexpr int PER_L = I_IN + 3 * I_BR + 5 * I_SQ + I_FIN + I_FOUT;
        for (int it = gw; it < 2 * PER_L; it += NGW) {
            const int l = it / PER_L; int r = it - l * PER_L;
            if (r < I_IN) { transpose_item(args.in[11] + (size_t)l * DM * NIN, NIN, (bf16_t*)(ws + W_IN) + (size_t)l * NIN * DM, DM, 0, scr, r, lane); continue; } r -= I_IN;
            if (r < 3 * I_BR) { const int w = r / I_BR; transpose_item(args.in[15 + w] + (size_t)l * 1024 * DM, DM, (bf16_t*)(ws + W_BR) + (size_t)l * DM * 3072, 3072, 1024 * w, scr, r - w * I_BR, lane); continue; } r -= 3 * I_BR;
            if (r < 5 * I_SQ) { const int w = r / I_SQ; const int src = (w == 0) ? 18 : 20 + w;
                const size_t dsto = (w == 0) ? W_MIXO : (w == 1) ? W_MQT : (w == 2) ? W_MKT : (w == 3) ? W_MVT : W_MOT;
                transpose_item(args.in[src] + (size_t)l * DM * DM, DM, (bf16_t*)(ws + dsto) + (size_t)l * DM * DM, DM, 0, scr, r - w * I_SQ, lane); continue; } r -= 5 * I_SQ;
            if (r < I_FIN) { transpose_item(args.in[27] + (size_t)l * DM * FF2, FF2, (bf16_t*)(ws + W_FIN) + (size_t)l * FF2 * DM, DM, 0, scr, r, lane); continue; } r -= I_FIN;
            transpose_item(args.in[30] + (size_t)l * FF * DM, DM, (bf16_t*)(ws + W_FOUT) + (size_t)l * DM * FF, FF, 0, scr, r, lane);
        }
        cvt_plain(args.in[21], (bf16_t*)(ws + W_MQN), (size_t)2 * DM * DM / 8, gtid, gthreads);
        cvt_plain(args.in[0], XB, (size_t)MP * DM / 8, gtid, gthreads);
        cvt_plain(args.in[1], XB + (size_t)MP * DM, (size_t)MS * DM / 8, gtid, gthreads);
        cvt_plain(args.in[2], MEMB, (size_t)512 * DM / 8, gtid, gthreads);
        for (int i = gtid; i < 4096 * 32; i += gthreads) { const int pos = i >> 5, d = i & 31;
            const float inv = exp2f(-(float)d * (13.287712379549449f / 32.f));
            const float ang = (float)pos * inv;
            const double rev = (double)ang * 0.15915494309189535; const float fr = (float)(rev - rint(rev));
            ((float*)(ws + WS_ROPE))[pos * 64 + d] = __builtin_amdgcn_cosf(fr); ((float*)(ws + WS_ROPE))[pos * 64 + 32 + d] = __builtin_amdgcn_sinf(fr); }
        for (int i = gtid; i < 16 * 256; i += gthreads) { const int h = i >> 8, rel = (i & 255) - 191; LUTA[i] = (rel <= 64) ? args.in[12][t5_bucket(rel) * 16 + h] * LOG2E : 0.f; }
        for (int i = gtid; i < 2 * 16 * 640; i += gthreads) { const int lh = i / 640, rel = (i % 640) - 575; int c = rel < -256 ? -256 : (rel > 256 ? 256 : rel);
            LUTC[i] = args.in[14][(size_t)lh * 513 + c + 256] * LOG2E; }
    }
    SEAM(0);

    for (int l = 0; l < 2; ++l) {
        const int pb = 1 + 15 * l;
        if (hi <= pb || lo >= pb + 15) continue;
        int bxl = blockIdx.x; asm volatile("" : "+s"(bxl));
        unsigned char* wsl = args.ws; asm volatile("" : "+s"(wsl));
        bf16_t* const XB = (bf16_t*)(wsl + WS_XB); float* const X = (float*)(wsl + WS_X);
        bf16_t* const P = (bf16_t*)(wsl + WS_R1); bf16_t* const U = (bf16_t*)(wsl + WS_R1);
        bf16_t* const OB = (bf16_t*)(wsl + WS_OB); float* const TMP = (float*)(wsl + WS_TMP); bf16_t* const MIX = (bf16_t*)(wsl + WS_MIX);
        bf16_t* const H = (bf16_t*)(wsl + WS_H); float* const UPD = (float*)(wsl + WS_UPD); bf16_t* const S0T = (bf16_t*)(wsl + WS_S0T);
        bf16_t* const MEMB = (bf16_t*)(wsl + WS_MEMB); bf16_t* const PM = (bf16_t*)(wsl + WS_PM);
        bf16_t* const QM = (bf16_t*)(wsl + WS_QM); bf16_t* const OM = (bf16_t*)(wsl + WS_OM);
        const float* const ROPE = (const float*)(wsl + WS_ROPE);
        float* const LUTA = (float*)(wsl + WS_LUT); float* const LUTC = LUTA + 16 * 256;
        const bf16_t* WinT = (const bf16_t*)(wsl + W_IN) + (size_t)l * NIN * DM;
        const bf16_t* WbrT = (const bf16_t*)(wsl + W_BR) + (size_t)l * DM * 3072;
        const bf16_t* WmixoT = (const bf16_t*)(wsl + W_MIXO) + (size_t)l * DM * DM;
        const bf16_t* WmqN = (const bf16_t*)(wsl + W_MQN) + (size_t)l * DM * DM;
        const bf16_t* WmqT = (const bf16_t*)(wsl + W_MQT) + (size_t)l * DM * DM;
        const bf16_t* WmkT = (const bf16_t*)(wsl + W_MKT) + (size_t)l * DM * DM;
        const bf16_t* WmvT = (const bf16_t*)(wsl + W_MVT) + (size_t)l * DM * DM;
        const bf16_t* WmoT = (const bf16_t*)(wsl + W_MOT) + (size_t)l * DM * DM;
        const bf16_t* WfinT = (const bf16_t*)(wsl + W_FIN) + (size_t)l * FF2 * DM;
        const bf16_t* WfoutT = (const bf16_t*)(wsl + W_FOUT) + (size_t)l * DM * FF;
        bf16_t* MKB = (bf16_t*)(wsl + WS_MKB) + (size_t)l * 512 * DM; bf16_t* MVB = (bf16_t*)(wsl + WS_MVB) + (size_t)l * 512 * DM;
        bf16_t* MBT = (bf16_t*)(wsl + WS_MBT) + (size_t)l * 2 * 1024 * DM; bf16_t* NBT = (bf16_t*)(wsl + WS_NBT) + (size_t)l * 2 * DM * 1024;

        if (PH_EN(0) && IN(pb + 0)) { int tid = threadIdx.x; asm volatile("" : "+v"(tid)); int gw = gw0; asm volatile("" : "+s"(gw)); const int lane = tid & 63; const int gtid = gw * 64 + lane; (void)gtid; (void)lane;
            { pg8::Gemm g{XB, WinT, DM, DM, DM, 0, 0, 0, 0, 0}; pg8::Order S; S.init(33, 53, 1, G, bxl);
              pg8::EpiOut E{P, NIN, 0, 0, nullptr, 0, 0, 1.f, 0};
              pg8::gemm_phase<pg8::EpiOut>(lds, g, S, E); }
            {
              pg8::Gemm g{MEMB, WmkT, DM, DM, DM, 0, 0, (long)2 * DM * DM, 0, 0}; pg8::Order S; S.init(2, 8, 2, G, G - 1 - bxl);
              pg8::EpiOut E{MKB, DM, (long)2 * 512 * DM, 0, dout + O_MKP + (size_t)l * 512 * DM, DM, (long)(O_MVP - O_MKP), 1.f, 0};
              pg8::gemm_phase<pg8::EpiOut>(lds, g, S, E); }
        }
        SEAM(pb + 0);

        if (PH_EN(1) && IN(pb + 1)) { int tid = threadIdx.x; asm volatile("" : "+v"(tid)); int gw = gw0; asm volatile("" : "+s"(gw)); const int lane = tid & 63; const int gtid = gw * 64 + lane; (void)gtid; (void)lane;
            for (int it = gw; it < 1024; it += NGW) {
                int lane = threadIdx.x & 63; asm volatile("" : "+v"(lane));
                const int n = it & 63, h = (it >> 6) & 7, b = it >> 9;
                const float lg = log2f(1.f - exp2f(-5.f - (float)h));
                LAS unsigned char* kt = lds + wave * WREG; LAS unsigned char* vtile = kt + 9216;
                const size_t R0 = (size_t)b * SEQ + 64 * n;
#pragma unroll
                for (int t = 0; t < 4; ++t) { const int idx = lane + 64 * t, tok = idx >> 2, c = idx & 3; const int pos = 64 * n + tok;
                    bf16_t* qp = P + (R0 + tok) * NIN + C_QB + 64 * h + 8 * c; bf16_t* kp = P + (R0 + tok) * NIN + C_KB + 64 * h + 8 * c;
                    float q1[8], q2[8], k1[8], k2[8], cs[8], sn[8];
                    unpack8(*(const u32x4*)qp, q1); unpack8(*(const u32x4*)(qp + 32), q2); unpack8(*(const u32x4*)kp, k1); unpack8(*(const u32x4*)(kp + 32), k2);
                    const float* rp = ROPE + pos * 64 + 8 * c;
                    *(f32x4*)&cs[0] = *(const f32x4*)rp; *(f32x4*)&cs[4] = *(const f32x4*)(rp + 4); *(f32x4*)&sn[0] = *(const f32x4*)(rp + 32); *(f32x4*)&sn[4] = *(const f32x4*)(rp + 36);
                    float a1[8], a2[8], b1[8], b2[8];
#pragma unroll
                    for (int e = 0; e < 8; ++e) { a1[e] = q1[e] * cs[e] - q2[e] * sn[e]; a2[e] = q2[e] * cs[e] + q1[e] * sn[e];
                        b1[e] = (k1[e] * cs[e] - k2[e] * sn[e]) * 0.125f; b2[e] = (k2[e] * cs[e] + k1[e] * sn[e]) * 0.125f; }
                    *(u32x4*)qp = pack8(a1); *(u32x4*)(qp + 32) = pack8(a2); *(u32x4*)kp = pack8(b1); *(u32x4*)(kp + 32) = pack8(b2);
                    const float w = ex2((float)(63 - tok) * lg);
#pragma unroll
                    for (int e = 0; e < 8; ++e) { b1[e] *= w; b2[e] *= w; }
                    *(LAS u32x4*)(kt + tok * 144 + c * 16) = pack8(b1); *(LAS u32x4*)(kt + tok * 144 + 64 + c * 16) = pack8(b2); }
                const LAS unsigned char* ktl = kt + tr_lane_off<144, false>(lane); const LAS unsigned char* vtl = vtile + tr_lane_off<144, false>(lane);
                float* updp = UPD + (size_t)it * 8192;
#pragma unroll 1
                for (int vh = 0; vh < 2; ++vh) {
#pragma unroll
                    for (int i = 0; i < 8; ++i) { const int row = 8 * i + (lane >> 3), ch = lane & 7;
                        *(LAS u32x4*)(vtile + row * 144 + ch * 16) = *(const u32x4*)(P + (R0 + row) * NIN + C_VB + 128 * h + 64 * vh + 8 * ch); }
#pragma unroll
                    for (int dvb = 0; dvb < 2; ++dvb)
#pragma unroll
                        for (int dkb = 0; dkb < 2; ++dkb) { f32x16 acc;
#pragma unroll
                            for (int r = 0; r < 16; ++r) acc[r] = 0.f;
#pragma unroll
                            for (int s = 0; s < 4; ++s) acc = __builtin_amdgcn_mfma_f32_32x32x16_bf16(tr_frag<144, false>(vtl, 16 * s, 32 * dvb), tr_frag<144, false>(ktl, 16 * s, 32 * dkb), acc, 0, 0, 0);
#pragma unroll
                            for (int r = 0; r < 16; ++r) updp[(64 * vh + 32 * dvb + crow(r) + 4 * (lane >> 5)) * 64 + 32 * dkb + (lane & 31)] = acc[r]; }
                }
            }
            __syncthreads();
            { LAS float* lc = (LAS float*)(lds + AT_LUTC); LAS float* la = (LAS float*)(lds + AT_LUTA);
              for (int i = tid; i < 16 * 640; i += 512) lc[i] = LUTC[l * 16 * 640 + i];
              for (int i = tid; i < 16 * 256; i += 512) la[i] = LUTA[i]; }
            __syncthreads();
            { const LAS float* lc = (const LAS float*)(lds + AT_LUTC); const LAS float* la = (const LAS float*)(lds + AT_LUTA);
              LAS unsigned char* vt = lds + wave * AT_VT;
              for (int idx = gw; idx < 4352; idx += NGW) {
                  int lane = threadIdx.x & 63; asm volatile("" : "+v"(lane)); const int r32 = lane & 31, hi5 = lane >> 5;
                  if (idx < 4096) { const int f = idx & 2047, half = f & 1, h = (f >> 7) & 15, b = idx >> 11; int n = (f >> 1) & 63; if (b) n = 63 - n;
                      const int c0 = n >= 8 ? n - 8 : 0; const size_t R0 = (size_t)b * SEQ; const int qpos = 64 * n + 32 * half + r32;
                      AttnSrc S{P + (R0 + 64 * c0) * NIN + C_KC + 64 * h, P + (R0 + 64 * c0) * NIN + C_VC + 64 * h, NIN, 0, n - c0 + 1, 64 * c0, nullptr, nullptr, 0, 0, 0};
                      attn_item<false, false>(P + (R0 + qpos) * NIN + C_QC + 64 * h, lc, h * 640 + 575 - qpos + 4 * hi5, 0.f, S, OB + (R0 + qpos) * 3072 + 2048 + 64 * h, true, vt, lane);
                  } else { const int sc = idx - 4096, sq = sc >> 4, h = sc & 15; const int tok = r32 & 15, qpos = 2048 + tok; const size_t R0 = (size_t)MP + sq * 16;
                      const float* ck = args.in[6] + ((size_t)(l * 16 + sq) * 512) * 1024 + 64 * h; const float* cv = args.in[7] + ((size_t)(l * 16 + sq) * 512) * 1024 + 64 * h;
                      AttnSrc S{ck, cv, 1024, 1, 8, 1536, P + R0 * NIN + C_KC + 64 * h, P + R0 * NIN + C_VC + 64 * h, NIN, 16, 2048};
                      attn_item<false, true>(P + (R0 + tok) * NIN + C_QC + 64 * h, lc, h * 640 + 575 - qpos + 4 * hi5, 0.f, S, OB + (R0 + tok) * 3072 + 2048 + 64 * h, r32 < 16, vt, lane); }
              }
              { const int w0 = (NGW >= 2048) ? 256 : 0, nw = NGW - w0;
                if (gw >= w0) for (int k = gw - w0; k < 4224; k += nw) {
                  int lane = threadIdx.x & 63; asm volatile("" : "+v"(lane)); const int r32 = lane & 31, hi5 = lane >> 5;
                  if (k < 4096) { const int f = k & 2047, half = f & 1, n = (f >> 1) & 63, h = (f >> 7) & 15, b = k >> 11, g2 = h >> 3;
                      const int c0 = n >= 2 ? n - 2 : 0; const size_t R0 = (size_t)b * SEQ; const int qpos = 64 * n + 32 * half + r32;
                      AttnSrc S{P + (R0 + 64 * c0) * NIN + C_KA + 64 * g2, P + (R0 + 64 * c0) * NIN + C_VA + 64 * g2, NIN, 0, n - c0 + 1, 64 * c0, nullptr, nullptr, 0, 0, 0};
                      attn_item<true, false>(P + (R0 + qpos) * NIN + C_QA + 64 * h, la, h * 256 + 191 - qpos + 4 * hi5, args.in[13][l * 16 + h] * LOG2E, S, OB + (R0 + qpos) * 3072 + 64 * h, true, vt, lane);
                  } else { const int sa = k - 4096, sq = sa >> 3, g2 = (sa >> 2) & 1, w4 = sa & 3; const int h = 8 * g2 + 2 * w4 + (r32 >> 4), tok = r32 & 15, qpos = 2048 + tok;
                      const size_t R0 = (size_t)MP + sq * 16;
                      const float* ck = args.in[3] + ((size_t)(l * 16 + sq) * 128) * 128 + 64 * g2; const float* cv = args.in[4] + ((size_t)(l * 16 + sq) * 128) * 128 + 64 * g2;
                      AttnSrc S{ck, cv, 128, 1, 2, 1920, P + R0 * NIN + C_KA + 64 * g2, P + R0 * NIN + C_VA + 64 * g2, NIN, 16, 2048};
                      attn_item<true, true>(P + (R0 + tok) * NIN + C_QA + 64 * h, la, h * 256 + 191 - qpos + 4 * hi5, args.in[13][l * 16 + h] * LOG2E, S, OB + (R0 + tok) * 3072 + 64 * h, true, vt, lane); }
                } }
            }
            __syncthreads();
            { pg8::Gemm g{MKB, WmqN, DM, DM, 512, (long)256 * DM, 512, 0, 512, 2}; pg8::Order S; S.init(1, 8, 8, G, bxl);
              pg8::EpiOut E{MBT, DM, (long)1024 * DM, (long)256 * DM, nullptr, 0, 0, 0.044194173824159216f * LOG2E, 2};
              pg8::gemm_phase<pg8::EpiOut>(lds, g, S, E); }
            { pg8::Gemm g{WmoT, MVB, DM, DM, 512, 0, 512, (long)256 * DM, 512, 2}; pg8::Order S; S.init(8, 1, 8, G, (bxl + G / 2) % G);
              pg8::EpiOut E{NBT, 1024, (long)DM * 1024, 256, nullptr, 0, 0, 1.f, 2};
              pg8::gemm_phase<pg8::EpiOut>(lds, g, S, E); }
            {
              const int n_sw = 2 * 128 * 16, n_bd = 2 * 512 * 128, n_ssw = 256 * 16, n_sbd = 256 * 128;
              for (int i = gtid; i < 2 * (n_sw + n_bd + n_ssw + n_sbd); i += gthreads) {
                  int r = i; const int kv = r & 1; r >>= 1; size_t srow; int scol; float* dst;
                  if (r < n_sw) { const int c8 = r & 15, i2 = (r >> 4) & 127, b = r >> 11; srow = (size_t)b * SEQ + 3968 + i2; scol = (kv ? C_VA : C_KA) + 8 * c8;
                      dst = dout + (kv ? O_SWAVP : O_SWAKP) + ((size_t)(l * 2 + b) * 128 + i2) * 128 + 8 * c8; }
                  else if ((r -= n_sw) < n_bd) { const int c8 = r & 127, i2 = (r >> 7) & 511, b = r >> 16; srow = (size_t)b * SEQ + 3584 + i2; scol = (kv ? C_VC : C_KC) + 8 * c8;
                      dst = dout + (kv ? O_BVP : O_BKP) + ((size_t)(l * 2 + b) * 512 + i2) * 1024 + 8 * c8; }
                  else if ((r -= n_bd) < n_ssw) { const int c8 = r & 15, row = r >> 4; srow = (size_t)MP + row; scol = (kv ? C_VA : C_KA) + 8 * c8;
                      dst = dout + (kv ? O_SWAVS : O_SWAKS) + ((size_t)l * 256 + row) * 128 + 8 * c8; }
                  else { r -= n_ssw; const int c8 = r & 127, row = r >> 7; srow = (size_t)MP + row; scol = (kv ? C_VC : C_KC) + 8 * c8;
                      dst = dout + (kv ? O_BVS : O_BKS) + ((size_t)l * 256 + row) * 1024 + 8 * c8; }
                  float f[8]; unpack8(*(const u32x4*)(P + srow * NIN + scol), f);
                  *(f32x4*)dst = (f32x4){f[0], f[1], f[2], f[3]}; *(f32x4*)(dst + 4) = (f32x4){f[4], f[5], f[6], f[7]}; }
            }
        }
        SEAM(pb + 1);

        if (PH_EN(2) && IN(pb + 2)) { int tid = threadIdx.x; asm volatile("" : "+v"(tid)); int gw = gw0; asm volatile("" : "+s"(gw)); const int lane = tid & 63; const int gtid = gw * 64 + lane; (void)gtid; (void)lane;
            for (int i = gtid; i < 16 * 8192; i += gthreads) { const int bh = i >> 13, e = i & 8191, h = bh & 7;
                const float g64 = ex2(64.f * log2f(1.f - exp2f(-5.f - (float)h)));
                const float* up = UPD + (size_t)bh * 64 * 8192 + e; bf16_t* sp = S0T + (size_t)bh * 64 * 8192 + e;
                float s = 0.f;
#pragma unroll 1
                for (int n0 = 0; n0 < 64; n0 += 16) { float u[16];
#pragma unroll
                    for (int j = 0; j < 16; ++j) u[j] = up[(size_t)(n0 + j) * 8192];
#pragma unroll
                    for (int j = 0; j < 16; ++j) { sp[(size_t)(n0 + j) * 8192] = f2bf(s); s = g64 * s + u[j]; } }
                const int dv = e >> 6, dk = e & 63;
                dout[O_RETP + ((size_t)(l * 2 + (bh >> 3)) * 8 + h) * 8192 + dk * 128 + dv] = s; }
            for (int it = gw; it < 128; it += NGW) { const int sq = it >> 3, h = it & 7;
                const float lg = log2f(1.f - exp2f(-5.f - (float)h));
                LAS float* ql = (LAS float*)(lds + wave * WREG); LAS float* kl = ql + 1024; LAS float* vl = kl + 1024; LAS float* qk = vl + 2048;
                const size_t R0 = (size_t)MP + sq * 16;
#pragma unroll
                for (int t = 0; t < 8; ++t) { const int pi = lane + 64 * t, tok = pi >> 5, d = pi & 31; const float cs = ROPE[(2048 + tok) * 64 + d], sn = ROPE[(2048 + tok) * 64 + 32 + d];
                    const bf16_t* qp = P + (R0 + tok) * NIN + C_QB + 64 * h + d; const bf16_t* kp = P + (R0 + tok) * NIN + C_KB + 64 * h + d;
                    const float q1 = bf2f(qp[0]), q2 = bf2f(qp[32]), k1 = bf2f(kp[0]), k2 = bf2f(kp[32]);
                    ql[tok * 64 + d] = q1 * cs - q2 * sn; ql[tok * 64 + 32 + d] = q2 * cs + q1 * sn;
                    kl[tok * 64 + d] = (k1 * cs - k2 * sn) * 0.125f; kl[tok * 64 + 32 + d] = (k2 * cs + k1 * sn) * 0.125f; }
#pragma unroll
                for (int t = 0; t < 32; ++t) { const int idx = lane + 64 * t, tok = idx >> 7, dv = idx & 127; vl[tok * 128 + dv] = bf2f(P[(R0 + tok) * NIN + C_VB + 128 * h + dv]); }
                LDS_WAIT(); asm volatile("" ::: "memory");
#pragma unroll
                for (int t = 0; t < 4; ++t) { const int idx = lane + 64 * t, i = idx >> 4, j = idx & 15; float s = 0.f;
                    for (int d = 0; d < 64; ++d) s += ql[i * 64 + d] * kl[j * 64 + d];
                    qk[idx] = (j <= i) ? s * ex2((float)(i - j) * lg) : 0.f; }
                LDS_WAIT(); asm volatile("" ::: "memory");
                const float* s0p = args.in[5] + ((size_t)(l * 16 + sq) * 8 + h) * 8192; float* snp = dout + O_RETS + ((size_t)(l * 16 + sq) * 8 + h) * 8192;
                const float g16 = ex2(16.f * lg);
#pragma unroll
                for (int t = 0; t < 16; ++t) { const int idx = lane + 64 * t; kl[idx] *= ex2((float)(15 - (idx >> 6)) * lg); }
                LDS_WAIT(); asm volatile("" ::: "memory");
#pragma unroll 1
                for (int c = 0; c < 2; ++c) { const int dv = lane + 64 * c;
                    float vj[16], cr[16];
#pragma unroll
                    for (int j = 0; j < 16; ++j) { vj[j] = vl[j * 128 + dv]; cr[j] = 0.f; }
#pragma unroll 2
                    for (int dk = 0; dk < 64; ++dk) { const float s0 = s0p[dk * 128 + dv];
                        float sn = g16 * s0;
#pragma unroll
                        for (int j = 0; j < 16; ++j) sn += kl[j * 64 + dk] * vj[j];
                        snp[dk * 128 + dv] = sn;
#pragma unroll
                        for (int i = 0; i < 16; ++i) cr[i] += ql[i * 64 + dk] * s0; }
#pragma unroll
                    for (int i = 0; i < 16; ++i) { float a = cr[i] * ex2((float)(i + 1) * lg);
#pragma unroll
                        for (int j = 0; j <= i; ++j) a += qk[i * 16 + j] * vj[j];
                        vl[i * 128 + dv] = a; }
                }
                LDS_WAIT(); asm volatile("" ::: "memory");
#pragma unroll 4
                for (int i = 0; i < 16; ++i) { const float x0 = vl[i * 128 + lane], x1 = vl[i * 128 + 64 + lane];
                    const float mean = wave_sum(x0 + x1) * (1.f / 128.f); const float d0 = x0 - mean, d1 = x1 - mean;
                    const float var = wave_sum(d0 * d0 + d1 * d1) * (1.f / 128.f); const float rstd = 1.f / sqrtf(var + RET_EPS);
#pragma unroll
                    for (int c = 0; c < 2; ++c) { const int dv = lane + 64 * c; const float g = bf2f(P[(R0 + i) * NIN + C_GR + 128 * h + dv]);
                        OB[(R0 + i) * 3072 + 1024 + 128 * h + dv] = f2bf((c ? d1 : d0) * rstd * g * sigmoidf_(g)); } }
                LDS_WAIT(); asm volatile("" ::: "memory");
            }
        }
        SEAM(pb + 2);

        if (PH_EN(3) && IN(pb + 3)) { int tid = threadIdx.x; asm volatile("" : "+v"(tid)); int gw = gw0; asm volatile("" : "+s"(gw)); const int lane = tid & 63; const int gtid = gw * 64 + lane; (void)gtid; (void)lane;
            for (int it = gw; it < 2048; it += NGW) {
                const int ib = it & 1, n = (it >> 1) & 63, h = (it >> 7) & 7, b = it >> 10;
                const float lg = log2f(1.f - exp2f(-5.f - (float)h));
                const int r32 = lane & 31, hi5 = lane >> 5;
                LAS unsigned char* vtile = lds + wave * WREG;
                const size_t R0 = (size_t)b * SEQ + 64 * n; const size_t rowi = R0 + 32 * ib + r32;
                const int nrow = 32 * (ib + 1);
                for (int i = 0; i < nrow / 4; ++i) { const int row = 4 * i + (lane >> 4), ch = lane & 15;
                    *(LAS u32x4*)(vtile + row * 272 + ch * 16) = *(const u32x4*)(P + (R0 + row) * NIN + C_VB + 128 * h + 8 * ch); }
                bf16x8 qf[4];
#pragma unroll
                for (int d0 = 0; d0 < 4; ++d0) qf[d0] = ldg_frag_bf16(P + rowi * NIN + C_QB + 64 * h + 16 * d0 + 8 * hi5);
                f32x16 o[4];
#pragma unroll
                for (int d = 0; d < 4; ++d)
#pragma unroll
                    for (int r = 0; r < 16; ++r) o[d][r] = 0.f;
                const LAS unsigned char* vtl = vtile + tr_lane_off<272, true>(lane);
                const int ii = 32 * ib + r32;
#pragma unroll 1
                for (int jb = 0; jb <= ib; ++jb) {
                    f32x16 p;
#pragma unroll
                    for (int r = 0; r < 16; ++r) p[r] = 0.f;
#pragma unroll
                    for (int d0 = 0; d0 < 4; ++d0) p = __builtin_amdgcn_mfma_f32_32x32x16_bf16(ldg_frag_bf16(P + (R0 + 32 * jb + r32) * NIN + C_KB + 64 * h + 16 * d0 + 8 * hi5), qf[d0], p, 0, 0, 0);
#pragma unroll
                    for (int r = 0; r < 16; ++r) { const int j = 32 * jb + crow(r) + 4 * hi5; p[r] = (ii >= j) ? p[r] * ex2((float)(ii - j) * lg) : 0.f; }
#pragma unroll
                    for (int s2 = 0; s2 < 2; ++s2) { const bf16x8 pf = pack_frag(p, 8 * s2);
#pragma unroll
                        for (int d = 0; d < 4; ++d) { const LAS unsigned char* base = vtl + (32 * jb + 16 * s2) * 272;
                            o[d] = __builtin_amdgcn_mfma_f32_32x32x16_bf16(tr_frag<272, true>(base, 0, 32 * d), pf, o[d], 0, 0, 0); } }
                }
                { const float sc = ex2((float)(ii + 1) * lg); const bf16_t* sp = S0T + (size_t)((b * 8 + h) * 64 + n) * 8192;
#pragma unroll
                  for (int d0 = 0; d0 < 4; ++d0) { float f[8]; unpack8(__builtin_bit_cast(u32x4, qf[d0]), f);
#pragma unroll
                      for (int e = 0; e < 8; ++e) f[e] *= sc;
                      const bf16x8 qs = __builtin_bit_cast(bf16x8, pack8(f));
#pragma unroll
                      for (int d = 0; d < 4; ++d) o[d] = __builtin_amdgcn_mfma_f32_32x32x16_bf16(ldg_frag_bf16(sp + (32 * d + r32) * 64 + 16 * d0 + 8 * hi5), qs, o[d], 0, 0, 0); } }
                float s = 0.f;
#pragma unroll
                for (int d = 0; d < 4; ++d)
#pragma unroll
                    for (int r = 0; r < 16; ++r) s += o[d][r];
                s += __shfl_xor(s, 32); const float mean = s * (1.f / 128.f);
                float q = 0.f;
#pragma unroll
                for (int d = 0; d < 4; ++d)
#pragma unroll
                    for (int r = 0; r < 16; ++r) { const float dd = o[d][r] - mean; q += dd * dd; }
                q += __shfl_xor(q, 32); const float rstd = 1.f / sqrtf(q * (1.f / 128.f) + RET_EPS);
#pragma unroll
                for (int d = 0; d < 4; ++d)
#pragma unroll
                    for (int rg = 0; rg < 4; ++rg) { const int dv = 32 * d + 8 * rg + 4 * hi5;
                        const u32x2 gw2 = *(const u32x2*)(P + rowi * NIN + C_GR + 128 * h + dv);
                        const float g0 = __uint_as_float(gw2.x << 16), g1 = __uint_as_float(gw2.x & 0xffff0000u), g2 = __uint_as_float(gw2.y << 16), g3 = __uint_as_float(gw2.y & 0xffff0000u);
                        u32x2 w; w.x = pk2((o[d][4 * rg] - mean) * rstd * g0 * sigmoidf_(g0), (o[d][4 * rg + 1] - mean) * rstd * g1 * sigmoidf_(g1));
                        w.y = pk2((o[d][4 * rg + 2] - mean) * rstd * g2 * sigmoidf_(g2), (o[d][4 * rg + 3] - mean) * rstd * g3 * sigmoidf_(g3));
                        *(u32x2*)(OB + rowi * 3072 + 1024 + 128 * h + dv) = w; }
                LDS_WAIT(); asm volatile("" ::: "memory");
            }
        }
        SEAM(pb + 3);

        if (PH_EN(4) && IN(pb + 4)) { int tid = threadIdx.x; asm volatile("" : "+v"(tid)); int gw = gw0; asm volatile("" : "+s"(gw)); const int lane = tid & 63; const int gtid = gw * 64 + lane; (void)gtid; (void)lane;
            pg8::Order S; S.init(33, 8, 1, G, bxl);
            { pg8::Gemm g{OB, WbrT, 3072, 3072, 1024, 0, 0, 0, 0, 0}; pg8::EpiGate<0> E{P, NIN, C_GA, TMP, MIX}; pg8::gemm_phase<pg8::EpiGate<0>>(lds, g, S, E); }
            { pg8::Gemm g{OB + 1024, WbrT + 1024, 3072, 3072, 1024, 0, 0, 0, 0, 0}; pg8::EpiGate<1> E{P, NIN, C_GB, TMP, MIX}; pg8::gemm_phase<pg8::EpiGate<1>>(lds, g, S, E); }
            { pg8::Gemm g{OB + 2048, WbrT + 2048, 3072, 3072, 1024, 0, 0, 0, 0, 0}; pg8::EpiGate<2> E{P, NIN, C_GC, TMP, MIX}; pg8::gemm_phase<pg8::EpiGate<2>>(lds, g, S, E); }
        }
        SEAM(pb + 4);

        if (PH_EN(5) && IN(pb + 5)) { int tid = threadIdx.x; asm volatile("" : "+v"(tid)); int gw = gw0; asm volatile("" : "+s"(gw)); const int lane = tid & 63; const int gtid = gw * 64 + lane; (void)gtid; (void)lane;
            pg8::Gemm g{MIX, WmixoT, DM, DM, DM, 0, 0, 0, 0, 0}; pg8::Order S; S.init(33, 8, 1, G, bxl);
            pg8::EpiResid E{l == 0 ? args.in[0] : X, l == 0 ? args.in[1] : nullptr, X, 0};
            pg8::gemm_phase<pg8::EpiResid>(lds, g, S, E);
        }
        SEAM(pb + 5);

#define LN_PHASE(GI, BI, OUT2) do { const float* gp_ = args.in[GI] + l * DM; const float* bp_ = args.in[BI] + l * DM; \
            for (int m_ = gw; m_ < MA; m_ += NGW) { float* xr_ = X + (size_t)m_ * DM; f32x4 v_[8]; float s_ = 0.f; \
                _Pragma("unroll") for (int j = 0; j < 8; ++j) { v_[j] = ((const f32x4*)xr_)[lane + 64 * j]; s_ += (v_[j][0] + v_[j][1]) + (v_[j][2] + v_[j][3]); } \
                const float mean_ = wave_sum(s_) * (1.f / DM); float q_ = 0.f; \
                _Pragma("unroll") for (int j = 0; j < 8; ++j) { v_[j] = v_[j] - mean_; q_ += (v_[j][0] * v_[j][0] + v_[j][1] * v_[j][1]) + (v_[j][2] * v_[j][2] + v_[j][3] * v_[j][3]); } \
                const float rstd_ = 1.f / sqrtf(wave_sum(q_) * (1.f / DM) + LN_EPS); \
                _Pragma("unroll") for (int j = 0; j < 8; ++j) { const f32x4 gg_ = ((const f32x4*)gp_)[lane + 64 * j], bb_ = ((const f32x4*)bp_)[lane + 64 * j]; const f32x4 o_ = v_[j] * rstd_ * gg_ + bb_; \
                    ((f32x4*)xr_)[lane + 64 * j] = o_; if (OUT2) ((f32x4*)((OUT2) + (size_t)m_ * DM))[lane + 64 * j] = o_; \
                    u32x2 w_; w_.x = pk2(o_[0], o_[1]); w_.y = pk2(o_[2], o_[3]); ((u32x2*)(XB + (size_t)m_ * DM))[lane + 64 * j] = w_; } } } while (0)

        if (PH_EN(6) && IN(pb + 6)) { int tid = threadIdx.x; asm volatile("" : "+v"(tid)); int gw = gw0; asm volatile("" : "+s"(gw)); const int lane = tid & 63; const int gtid = gw * 64 + lane; (void)gtid; (void)lane; LN_PHASE(19, 20, (float*)nullptr); }
        SEAM(pb + 6);

        if (PH_EN(7) && IN(pb + 7)) { int tid = threadIdx.x; asm volatile("" : "+v"(tid)); int gw = gw0; asm volatile("" : "+s"(gw)); const int lane = tid & 63; const int gtid = gw * 64 + lane; (void)gtid; (void)lane;
            { pg8::Gemm g{XB, MBT, DM, DM, DM, (long)SEQ * DM, 0, (long)1024 * DM, 0, 0}; pg8::Order S; S.init(16, 4, 2, G, bxl);
              pg8::EpiSoftmax E{PM, 1024, (long)SEQ * 1024};
              pg8::gemm_phase<pg8::EpiSoftmax>(lds, g, S, E); }
            { pg8::Gemm g{XB + (size_t)MP * DM, WmqT, DM, DM, DM, 0, 0, 0, 0, 0}; pg8::Order S; S.init(1, 8, 1, G, G - 1 - bxl);
              pg8::EpiOut E{QM, DM, 0, 0, nullptr, 0, 0, 1.f, 0};
              pg8::gemm_phase<pg8::EpiOut>(lds, g, S, E); }
        }
        SEAM(pb + 7);

        if (PH_EN(8) && IN(pb + 8)) { int tid = threadIdx.x; asm volatile("" : "+v"(tid)); int gw = gw0; asm volatile("" : "+s"(gw)); const int lane = tid & 63; const int gtid = gw * 64 + lane; (void)gtid; (void)lane;
            for (int it = vcu; it < 64; it += G) { const int sq = it >> 2, hd = it & 3;
                LAS float* Sl = (LAS float*)lds;
                LAS bf16_t* Pl = (LAS bf16_t*)(lds + 16 * 260 * 4);
                const int c16 = lane & 15, fq = lane >> 4;
                const float* ck = args.in[9] + ((size_t)(l * 16 + sq) * 256) * DM + 512 * hd; const float* cv = args.in[10] + ((size_t)(l * 16 + sq) * 256) * DM + 512 * hd;
                const bf16_t* qp = QM + (size_t)(sq * 16 + c16) * DM + 512 * hd;
#pragma unroll 1
                for (int kb2 = 0; kb2 < 2; ++kb2) { const int kb = 2 * wave + kb2; f32x4 acc = {0.f, 0.f, 0.f, 0.f};
#pragma unroll 4
                    for (int ds = 0; ds < 16; ++ds) acc = __builtin_amdgcn_mfma_f32_16x16x32_bf16(ldg_frag_bf16(qp + 32 * ds + 8 * fq), ldg_frag_f32(ck + (size_t)(16 * kb + c16) * DM + 32 * ds + 8 * fq), acc, 0, 0, 0);
#pragma unroll
                    for (int r = 0; r < 4; ++r) Sl[(4 * fq + r) * 260 + 16 * kb + c16] = acc[r] * (0.044194173824159216f * LOG2E); }
                __syncthreads();
#pragma unroll
                for (int rr = 0; rr < 2; ++rr) { const int q = 2 * wave + rr; float v[4];
#pragma unroll
                    for (int j = 0; j < 4; ++j) v[j] = Sl[q * 260 + lane + 64 * j];
                    const float mx = wave_max(fmaxf(fmaxf(v[0], v[1]), fmaxf(v[2], v[3])));
#pragma unroll
                    for (int j = 0; j < 4; ++j) v[j] = ex2(v[j] - mx);
                    const float inv = 1.f / wave_sum((v[0] + v[1]) + (v[2] + v[3]));
#pragma unroll
                    for (int j = 0; j < 4; ++j) Pl[q * 264 + lane + 64 * j] = f2bf(v[j] * inv); }
                __syncthreads();
#pragma unroll 1
                for (int db = 0; db < 4; ++db) { const int dcol = 64 * wave + 16 * db + c16; f32x4 acc = {0.f, 0.f, 0.f, 0.f};
#pragma unroll 2
                    for (int ks = 0; ks < 8; ++ks) { float f[8];
#pragma unroll
                        for (int j = 0; j < 8; ++j) f[j] = cv[(size_t)(32 * ks + 8 * fq + j) * DM + dcol];
                        const bf16x8 pa = *(const LAS bf16x8*)(Pl + c16 * 264 + 32 * ks + 8 * fq);
                        acc = __builtin_amdgcn_mfma_f32_16x16x32_bf16(pa, __builtin_bit_cast(bf16x8, pack8(f)), acc, 0, 0, 0); }
#pragma unroll
                    for (int r = 0; r < 4; ++r) OM[(size_t)(sq * 16 + 4 * fq + r) * DM + 512 * hd + dcol] = f2bf(acc[r]); }
                __syncthreads();
            }
        }
        SEAM(pb + 8);

        if (PH_EN(9) && IN(pb + 9)) { int tid = threadIdx.x; asm volatile("" : "+v"(tid)); int gw = gw0; asm volatile("" : "+s"(gw)); const int lane = tid & 63; const int gtid = gw * 64 + lane; (void)gtid; (void)lane;
            { pg8::Gemm g{PM, NBT, 1024, 1024, 1024, (long)SEQ * 1024, 0, (long)DM * 1024, 0, 0}; pg8::Order S; S.init(16, 8, 2, G, bxl);
              pg8::EpiResid E{X, nullptr, X, SEQ};
              pg8::gemm_phase<pg8::EpiResid>(lds, g, S, E); }
            { pg8::Gemm g{OM, WmoT, DM, DM, DM, 0, 0, 0, 0, 0}; pg8::Order S; S.init(1, 8, 1, G, G - 1 - bxl);
              pg8::EpiResid E{X, nullptr, X, MP};
              E.src0 = X + (size_t)MP * DM; E.dst = X + (size_t)MP * DM; E.zrows = 0;
              pg8::gemm_phase<pg8::EpiResid>(lds, g, S, E); }
        }
        SEAM(pb + 9);

        if (PH_EN(10) && IN(pb + 10)) { int tid = threadIdx.x; asm volatile("" : "+v"(tid)); int gw = gw0; asm volatile("" : "+s"(gw)); const int lane = tid & 63; const int gtid = gw * 64 + lane; (void)gtid; (void)lane; LN_PHASE(25, 26, (float*)nullptr); }
        SEAM(pb + 10);

        if (PH_EN(11) && IN(pb + 11)) { int tid = threadIdx.x; asm volatile("" : "+v"(tid)); int gw = gw0; asm volatile("" : "+s"(gw)); const int lane = tid & 63; const int gtid = gw * 64 + lane; (void)gtid; (void)lane;
            pg8::Gemm g{XB, WfinT, DM, DM, DM, 0, 0, 0, 0, 0}; pg8::Order S; S.init(33, 44, 1, G, bxl);
            pg8::EpiOut E{U, FF2, 0, 0, nullptr, 0, 0, 1.f, 0};
            pg8::gemm_phase<pg8::EpiOut>(lds, g, S, E);
        }
        SEAM(pb + 11);

        if (PH_EN(12) && IN(pb + 12)) { int tid = threadIdx.x; asm volatile("" : "+v"(tid)); int gw = gw0; asm volatile("" : "+s"(gw)); const int lane = tid & 63; const int gtid = gw * 64 + lane; (void)gtid; (void)lane;
            const float* cw = args.in[28] + (size_t)l * 3 * FF2; const float* cb = args.in[29] + (size_t)l * FF2;
            for (int it = gw; it < 528 * 11; it += NGW) { const int rr = it / 11, cbk = it - rr * 11; const int j0 = cbk * 512 + lane * 8; const int t0 = rr * 16;
                float w0[16], w1[16], w2[16], bb[16], um2[16], um1[16];
#pragma unroll
                for (int p2 = 0; p2 < 2; ++p2)
#pragma unroll
                    for (int e4 = 0; e4 < 2; ++e4) { const int col = j0 + p2 * FF + 4 * e4;
                        *(f32x4*)&w0[8 * p2 + 4 * e4] = *(const f32x4*)(cw + col); *(f32x4*)&w1[8 * p2 + 4 * e4] = *(const f32x4*)(cw + FF2 + col);
                        *(f32x4*)&w2[8 * p2 + 4 * e4] = *(const f32x4*)(cw + 2 * FF2 + col); *(f32x4*)&bb[8 * p2 + 4 * e4] = *(const f32x4*)(cb + col); }
                if (t0 >= MP) { const float* st = args.in[8] + ((size_t)(l * 16 + (t0 - MP) / 16) * 2) * FF2;
#pragma unroll
                    for (int p2 = 0; p2 < 2; ++p2)
#pragma unroll
                        for (int e4 = 0; e4 < 2; ++e4) { const int col = j0 + p2 * FF + 4 * e4; *(f32x4*)&um2[8 * p2 + 4 * e4] = *(const f32x4*)(st + col); *(f32x4*)&um1[8 * p2 + 4 * e4] = *(const f32x4*)(st + FF2 + col); }
                } else if ((t0 & (SEQ - 1)) == 0) {
#pragma unroll
                    for (int e = 0; e < 16; ++e) { um2[e] = 0.f; um1[e] = 0.f; }
                } else {
#pragma unroll
                    for (int p2 = 0; p2 < 2; ++p2) { float f[8]; unpack8(*(const u32x4*)(U + (size_t)(t0 - 2) * FF2 + j0 + p2 * FF), f);
#pragma unroll
                        for (int e = 0; e < 8; ++e) um2[8 * p2 + e] = f[e];
                        unpack8(*(const u32x4*)(U + (size_t)(t0 - 1) * FF2 + j0 + p2 * FF), f);
#pragma unroll
                        for (int e = 0; e < 8; ++e) um1[8 * p2 + e] = f[e]; }
                }
#pragma unroll 4
                for (int t = t0; t < t0 + 16; ++t) { float u0[16];
#pragma unroll
                    for (int p2 = 0; p2 < 2; ++p2) { float f[8]; unpack8(*(const u32x4*)(U + (size_t)t * FF2 + j0 + p2 * FF), f);
#pragma unroll
                        for (int e = 0; e < 8; ++e) u0[8 * p2 + e] = f[e]; }
                    float hv[8];
#pragma unroll
                    for (int e = 0; e < 8; ++e) { const float cg = w0[e] * um2[e] + w1[e] * um1[e] + w2[e] * u0[e] + bb[e]; const float cv = w0[8 + e] * um2[8 + e] + w1[8 + e] * um1[8 + e] + w2[8 + e] * u0[8 + e] + bb[8 + e];
                        hv[e] = gelu_erf(cg) * cv; }
                    *(u32x4*)(H + (size_t)t * FF + j0) = pack8(hv);
#pragma unroll
                    for (int e = 0; e < 16; ++e) { um2[e] = um1[e]; um1[e] = u0[e]; } }
            }
            for (int i = gtid; i < 36 * (FF2 / 8); i += gthreads) { const int c8 = i % (FF2 / 8), r = i / (FF2 / 8); size_t srow; float* dst;
                if (r < 4) { const int b = r >> 1, k = r & 1; srow = (size_t)b * SEQ + 4094 + k; dst = dout + O_FCP + ((size_t)(l * 2 + b) * 2 + k) * FF2 + 8 * c8; }
                else { const int r2 = r - 4, sq = r2 >> 1, k = r2 & 1; srow = (size_t)MP + sq * 16 + 14 + k; dst = dout + O_FCS + ((size_t)(l * 16 + sq) * 2 + k) * FF2 + 8 * c8; }
                float f[8]; unpack8(*(const u32x4*)(U + srow * FF2 + 8 * c8), f);
                *(f32x4*)dst = (f32x4){f[0], f[1], f[2], f[3]}; *(f32x4*)(dst + 4) = (f32x4){f[4], f[5], f[6], f[7]}; }
        }
        SEAM(pb + 12);

        if (PH_EN(13) && IN(pb + 13)) { int tid = threadIdx.x; asm volatile("" : "+v"(tid)); int gw = gw0; asm volatile("" : "+s"(gw)); const int lane = tid & 63; const int gtid = gw * 64 + lane; (void)gtid; (void)lane;
            pg8::Gemm g{H, WfoutT, FF, FF, FF, 0, 0, 0, 0, 0}; pg8::Order S; S.init(33, 8, 1, G, bxl);
            pg8::EpiResid E{X, nullptr, X, 0};
            pg8::gemm_phase<pg8::EpiResid>(lds, g, S, E);
        }
        SEAM(pb + 13);

        if (PH_EN(14) && IN(pb + 14)) { int tid = threadIdx.x; asm volatile("" : "+v"(tid)); int gw = gw0; asm volatile("" : "+s"(gw)); const int lane = tid & 63; const int gtid = gw * 64 + lane; (void)gtid; (void)lane; float* o2 = (l == 1) ? dout + O_Y : nullptr; LN_PHASE(31, 32, o2); }
        SEAM(pb + 14);
    }
#if defined(DBG_OFF)
    if (lo == NPHASE) { const int gt = (gw0 * 64 + (threadIdx.x & 63));
        for (size_t i = gt; i < O_END; i += (size_t)gthreads) { const bool in = i >= (size_t)(DBG_OFF) && i < (size_t)(DBG_OFF) + (size_t)(DBG_LEN); dout[i] = in ? dout[i] * (float)(DBG_SCALE) : 0.f; } }
#endif
#undef IN
#undef SEAM
}

extern "C" void kernel_launch(void* const* d_in, const int* in_sizes, int n_in, void* d_out, int out_size, void* d_ws, size_t ws_size, hipStream_t stream) {
    static int grid = 0;
    if (grid == 0) {
        if (n_in != 33 || out_size != (int)O_END || ws_size < WS_END) { fprintf(stderr, "kernel_launch: unexpected shapes (n_in %d, out %d, ws %zu)\n", n_in, out_size, ws_size); grid = -1; return; }
        int dev = 0, cus = 0;
        if (hipGetDevice(&dev) != hipSuccess || hipDeviceGetAttribute(&cus, hipDeviceAttributeMultiprocessorCount, dev) != hipSuccess) { grid = -1; return; }
        if (hipFuncSetAttribute((const void*)enc_fwd, hipFuncAttributeMaxDynamicSharedMemorySize, LDS_BYTES) != hipSuccess) { fprintf(stderr, "kernel_launch: hipFuncSetAttribute failed\n"); grid = -1; return; }
        int per_cu = 0;
        if (hipOccupancyMaxActiveBlocksPerMultiprocessor(&per_cu, (const void*)enc_fwd, 512, LDS_BYTES) != hipSuccess || per_cu < 1) fprintf(stderr, "kernel_launch: occupancy query reports %d\n", per_cu);
        (void)hipGetLastError();
        grid = cus;
    }
    if (grid < 0) return;
    (void)hipMemsetAsync((char*)d_ws + WS_CTL, 0, CTL_ZERO_BYTES, stream);
    Args a{};
    for (int i = 0; i < 33; ++i) a.in[i] = (const float*)d_in[i];
    a.out = (float*)d_out; a.ws = (unsigned char*)d_ws;
#if N_LAUNCH_MODE == 0
    a.ph_lo = 0; a.ph_hi = NPHASE;
    hipLaunchKernelGGL(enc_fwd, dim3(grid), dim3(512), LDS_BYTES, stream, a);
#else
    for (int p = 0; p < NPHASE; ++p) { a.ph_lo = p; a.ph_hi = p + 1; hipLaunchKernelGGL(enc_fwd, dim3(grid), dim3(512), LDS_BYTES, stream, a); }
#if defined(DBG_OFF)
    a.ph_lo = NPHASE; a.ph_hi = NPHASE + 1; hipLaunchKernelGGL(enc_fwd, dim3(grid), dim3(512), LDS_BYTES, stream, a);
#endif
#endif
}
```

```cpp
#include <hip/hip_runtime.h>
#include <cstdio>
#include <cstdint>

#define LAS __attribute__((address_space(3)))
#define GAS __attribute__((address_space(1)))
typedef unsigned short bf16_t;
typedef short bf16x8 __attribute__((ext_vector_type(8)));
typedef short s16x4 __attribute__((ext_vector_type(4)));
typedef float f32x4 __attribute__((ext_vector_type(4)));
typedef float f32x2 __attribute__((ext_vector_type(2)));
typedef float f32x16 __attribute__((ext_vector_type(16)));
typedef unsigned u32x4 __attribute__((ext_vector_type(4)));
typedef unsigned u32x2 __attribute__((ext_vector_type(2)));
typedef __bf16 bf16x2_t __attribute__((ext_vector_type(2)));

#ifndef N_LAUNCH_MODE
#define N_LAUNCH_MODE 0
#endif

constexpr int DM = 2048, SEQ = 4096, MP = 8192, MS = 256, MA = 8448;
constexpr int NIN = 13568, FF = 5632, FF2 = 11264;
constexpr int C_QA = 0, C_KA = 1024, C_VA = 1152, C_QB = 1280, C_KB = 1792, C_VB = 2304, C_GR = 3328, C_QC = 4352, C_KC = 5376, C_VC = 6400, C_GA = 7424, C_GB = 9472, C_GC = 11520;
constexpr float LN_EPS = 1e-5f, RET_EPS = 1e-5f;
constexpr float LOG2E = 1.4426950408889634f;
constexpr float DN_ALPHA = 1.4142135623730951f;

constexpr size_t O_Y = 0, O_YS = 16777216, O_SWAKP = 17301504, O_SWAVP = 17367040, O_RETP = 17432576, O_BKP = 17694720, O_BVP = 19791872,
                 O_FCP = 21889024, O_MKP = 21979136, O_MVP = 24076288, O_SWAKS = 26173440, O_SWAVS = 26238976, O_RETS = 26304512,
                 O_BKS = 28401664, O_BVS = 28925952, O_FCS = 29450240, O_END = 30171136;

constexpr size_t MiB = 1u << 20;
constexpr size_t WS_CTL = 0, CTL_ZERO_BYTES = 64 * 1024;
constexpr size_t WS_ROPE = 1 * MiB;
constexpr size_t WS_LUT = 2 * MiB;
constexpr size_t WS_MEMB = 3 * MiB;
constexpr size_t WS_MKB = 5 * MiB;
constexpr size_t WS_MVB = 9 * MiB;
constexpr size_t WS_MBT = 13 * MiB;
constexpr size_t WS_NBT = 29 * MiB;
constexpr size_t WS_QM = 45 * MiB;
constexpr size_t WS_OM = 46 * MiB;
constexpr size_t WS_PM = 47 * MiB;
constexpr size_t WS_XB = 63 * MiB;
constexpr size_t WS_X = 96 * MiB;
constexpr size_t WS_W = 162 * MiB;
constexpr size_t W_IN = WS_W;
constexpr size_t W_BR = W_IN + 2 * 53 * MiB;
constexpr size_t W_MIXO = W_BR + 2 * 12 * MiB;
constexpr size_t W_MQN = W_MIXO + 16 * MiB;
constexpr size_t W_MQT = W_MQN + 16 * MiB;
constexpr size_t W_MKT = W_MQT + 16 * MiB;
constexpr size_t W_MVT = W_MKT + 16 * MiB;
constexpr size_t W_MOT = W_MVT + 16 * MiB;
constexpr size_t W_FIN = W_MOT + 16 * MiB;
constexpr size_t W_FOUT = W_FIN + 2 * 44 * MiB;
constexpr size_t WS_R1 = W_FOUT + 2 * 22 * MiB;
constexpr size_t WS_R2 = WS_R1 + 219 * MiB;
constexpr size_t WS_OB = WS_R2;
constexpr size_t WS_TMP = WS_R2 + 50 * MiB;
constexpr size_t WS_MIX = WS_TMP + 66 * MiB;
constexpr size_t WS_H = WS_R2;
constexpr size_t WS_UPD = WS_TMP;
constexpr size_t WS_S0T = WS_TMP + 64 * MiB;
constexpr size_t WS_END = WS_MIX + 33 * MiB;
static_assert(WS_R1 == 520 * MiB, "ws map");
static_assert(WS_S0T + 32 * MiB <= WS_END, "ws map");
static_assert(WS_END <= 1000 * MiB, "ws map");

constexpr int RING_BYTES = 131072;
constexpr int SMTAB_OFF = RING_BYTES;
constexpr int MISC_OFF = 147456;
constexpr int LDS_BYTES = 148480;
constexpr int WREG = 18432;
constexpr int AT_VT = 9216;
constexpr int AT_LUTC = 8 * AT_VT;
constexpr int AT_LUTA = AT_LUTC + 16 * 640 * 4;
static_assert(AT_LUTA + 16 * 256 * 4 <= RING_BYTES, "lds map");

__device__ __forceinline__ float bf2f(unsigned short b) { return __uint_as_float((unsigned)b << 16); }
__device__ __forceinline__ unsigned pk2(float lo, float hi) { f32x2 v = {lo, hi}; bf16x2_t b = __builtin_convertvector(v, bf16x2_t); return __builtin_bit_cast(unsigned, b); }
__device__ __forceinline__ unsigned short f2bf(float f) { return (unsigned short)(pk2(f, 0.f) & 0xffffu); }
__device__ __forceinline__ void unpack8(const u32x4 w, float (&f)[8]) {
#pragma unroll
    for (int i = 0; i < 4; ++i) { f[2 * i] = __uint_as_float(w[i] << 16); f[2 * i + 1] = __uint_as_float(w[i] & 0xffff0000u); }
}
__device__ __forceinline__ u32x4 pack8(const float (&f)[8]) { u32x4 w; w.x = pk2(f[0], f[1]); w.y = pk2(f[2], f[3]); w.z = pk2(f[4], f[5]); w.w = pk2(f[6], f[7]); return w; }
__device__ __forceinline__ float ex2(float x) { return __builtin_amdgcn_exp2f(x); }
__device__ __forceinline__ float rcp(float x) { return __builtin_amdgcn_rcpf(x); }
__device__ __forceinline__ float sigmoidf_(float g) { return rcp(1.f + ex2(-g * LOG2E)); }
template <int MASK> __device__ __forceinline__ float swz_xor(float v) { return __int_as_float(__builtin_amdgcn_ds_swizzle(__float_as_int(v), (MASK << 10) | 0x1f)); }
__device__ __forceinline__ float half_sum(float v) { auto rr = __builtin_amdgcn_permlane32_swap(__float_as_uint(v), __float_as_uint(v), false, false); return __uint_as_float(rr[0]) + __uint_as_float(rr[1]); }
__device__ __forceinline__ float half_max(float v) { auto rr = __builtin_amdgcn_permlane32_swap(__float_as_uint(v), __float_as_uint(v), false, false); return fmaxf(__uint_as_float(rr[0]), __uint_as_float(rr[1])); }
__device__ __forceinline__ float wave_sum(float v) { v += swz_xor<1>(v); v += swz_xor<2>(v); v += swz_xor<4>(v); v += swz_xor<8>(v); v += swz_xor<16>(v); return half_sum(v); }
__device__ __forceinline__ float wave_max(float v) { v = fmaxf(v, swz_xor<1>(v)); v = fmaxf(v, swz_xor<2>(v)); v = fmaxf(v, swz_xor<4>(v)); v = fmaxf(v, swz_xor<8>(v)); v = fmaxf(v, swz_xor<16>(v)); return half_max(v); }
__device__ __forceinline__ int fresh_lane() { int l; asm volatile("v_mbcnt_lo_u32_b32 %0, -1, 0\n\tv_mbcnt_hi_u32_b32 %0, -1, %0" : "=v"(l)); return l; }
#define LDS_WAIT() asm volatile("s_waitcnt lgkmcnt(0)" ::: "memory")
#define VM_WAIT() asm volatile("s_waitcnt vmcnt(0)" ::: "memory")

__device__ __forceinline__ float gelu_erf(float v) {
    const float av = fabsf(v), t = rcp(av * 0.2316418882f + 1.0f);
    float q = t * 0.5307027145f + (-0.7265760135f); q = q * t + 0.7107068705f; q = q * t + (-0.142248368f); q = q * t + 0.127414796f; q = q * t;
    const float e = ex2((v * v) * (-0.72134752044f));
    const float m = v * (q * e);
    return v < 0.f ? m : v - m;
}

namespace pg8 {
constexpr int BM = 256, BK = 64, HALF = 128, HTB = HALF * BK * 2, STAGE_BYTES = 8 * HTB, NXCD = 8, WGM = 8;
__host__ __device__ __forceinline__ int lds_byte(int r, int c) { const int st = (r >> 4) * 2 + (c >> 5), rr = r & 15, cc = c & 31, ob = rr * 64 + cc * 2; return st * 1024 + (ob ^ (((ob >> 9) & 1) << 5)); }
__host__ __device__ __forceinline__ void stage_rc(int b, int& R, int& C) { const int st = b / 1024, sb = b % 1024, swz = sb ^ (((sb >> 9) & 1) << 5); R = (st >> 1) * 16 + swz / 64; C = (st & 1) * 32 + (swz % 64) / 2; }
__host__ __device__ __forceinline__ int perm32(int rho) { const int n = rho >> 4, i = rho & 15; return 8 * (i >> 2) + 4 * n + (i & 3); }

struct Unit { int pm, pn, z; };
struct Gemm { const bf16_t* A; const bf16_t* Bt; int lda, ldb, K; long zsA1, zsA0, zsB1, zsB0; int zshift; };

struct Order {
    int nM, nN, per, total, G, c, zin;
    __device__ __forceinline__ void init(int nM_, int nN_, int nZ_, int G_, int c_) { nM = nM_; nN = nN_; per = nM_ * nN_; total = per * nZ_; G = G_; c = c_; zin = 0; }
    __device__ __forceinline__ void init_inner(int nM_, int nN_, int nZ_, int G_, int c_) { nM = nM_; nN = nN_; per = nM_ * nN_; total = per; G = G_; c = c_; zin = nZ_; }
    __device__ __forceinline__ bool next(int i, Unit& u) const {
        int zi = 0; if (zin > 0) { zi = i % zin; i = i / zin; }
        const long L = (long)i * G + c; if (L >= total) return false;
        int wgid = (int)L; { const int q = total / NXCD, r = total % NXCD, xcd = wgid % NXCD, off = wgid / NXCD; wgid = (xcd < r ? xcd * (q + 1) : r * (q + 1) + (xcd - r) * q) + off; }
        u.z = wgid / per; wgid -= u.z * per; if (zin > 0) u.z = zi;
        const int nig = WGM * nN, gid = wgid / nig, fm = gid * WGM, gsz = (nM - fm) < WGM ? (nM - fm) : WGM;
        u.pm = fm + ((wgid % nig) % gsz); u.pn = (wgid % nig) / gsz; return true;
    }
};

typedef f32x4 Acc[2][2][4][2];

struct EpiGateR {
    static constexpr bool PERM = true, KEEP = true;
    const bf16_t* Gt; int ldg, gcol; bf16_t* MIX;
    __device__ __forceinline__ bool keep(const Unit& u) const { return u.z < 2; }
    __device__ __forceinline__ void operator()(Acc& acc, const Unit& u, int wr, int wc, int fr, int fq, int ui, LAS unsigned char* lds) const {
        const int row0 = u.pm * BM + wr * 64 + fr, col0 = u.pn * BM + wc * 32 + 8 * fq; const int z = u.z;
#pragma unroll
        for (int ai = 0; ai < 2; ++ai)
#pragma unroll
            for (int mp = 0; mp < 2; ++mp) {
                u32x4 g0[2][2], g1[2][2];
#pragma unroll
                for (int mm = 0; mm < 2; ++mm)
#pragma unroll
                    for (int bj = 0; bj < 2; ++bj) { const size_t row = (size_t)(row0 + ai * HALF + (2 * mp + mm) * 16); const bf16_t* gp = Gt + row * ldg + gcol + 2048 * z + col0 + bj * HALF;
                        g0[mm][bj] = *(const u32x4*)gp; g1[mm][bj] = (z < 2) ? *(const u32x4*)(gp + 2048) : g0[mm][bj]; }
#pragma unroll
                for (int mm = 0; mm < 2; ++mm)
#pragma unroll
                    for (int bj = 0; bj < 2; ++bj) { const int m = 2 * mp + mm; float a[8], b[8]; unpack8(g0[mm][bj], a); unpack8(g1[mm][bj], b); float f[8];
#pragma unroll
                        for (int e = 0; e < 8; ++e) { const float ea = ex2(-a[e] * LOG2E), eb = ex2(-b[e] * LOG2E); f[e] = (z < 2) ? (1.f + eb) * rcp(1.f + ea) : rcp(1.f + ea); }
#pragma unroll
                        for (int e = 0; e < 4; ++e) { acc[ai][bj][m][0][e] *= f[e]; acc[ai][bj][m][1][e] *= f[4 + e]; }
                        if (z == 2) { const size_t row = (size_t)(row0 + ai * HALF + m * 16); const f32x4 v0 = acc[ai][bj][m][0], v1 = acc[ai][bj][m][1];
                            u32x4 w; w.x = pk2(v0[0], v0[1]); w.y = pk2(v0[2], v0[3]); w.z = pk2(v1[0], v1[1]); w.w = pk2(v1[2], v1[3]); *(u32x4*)(MIX + row * DM + col0 + bj * HALF) = w; } }
                asm volatile("" ::: "memory"); }
    }
};
struct EpiOut {
    static constexpr bool PERM = true, KEEP = false;
    bf16_t* O; int ldo; long zsO1, zsO0; float* F; int ldf; long zsF; float scale; int zshift;
    __device__ __forceinline__ void operator()(Acc& acc, const Unit& u, int wr, int wc, int fr, int fq, int ui, LAS unsigned char* lds) const {
        const int zh = u.z >> zshift, zl = u.z & ((1 << zshift) - 1);
        const int row0 = u.pm * BM + wr * 64 + fr, col0 = u.pn * BM + wc * 32 + 8 * fq;
        bf16_t* ob = O ? O + zh * zsO1 + zl * zsO0 : nullptr; float* fb = F ? F + (long)u.z * zsF : nullptr;
#pragma unroll
        for (int ai = 0; ai < 2; ++ai)
#pragma unroll
            for (int m = 0; m < 4; ++m) { const size_t row = (size_t)(row0 + ai * HALF + m * 16);
#pragma unroll
                for (int bj = 0; bj < 2; ++bj) { const f32x4 v0 = acc[ai][bj][m][0] * scale, v1 = acc[ai][bj][m][1] * scale; const int col = col0 + bj * HALF;
                    if (ob) { u32x4 w; w.x = pk2(v0[0], v0[1]); w.y = pk2(v0[2], v0[3]); w.z = pk2(v1[0], v1[1]); w.w = pk2(v1[2], v1[3]); *(u32x4*)(ob + row * ldo + col) = w; }
                    if (fb) { *(f32x4*)(fb + row * ldf + col) = v0; *(f32x4*)(fb + row * ldf + col + 4) = v1; } } }
    }
};
template <int STEP> struct EpiGate {
    static constexpr bool PERM = true, KEEP = false;
    const bf16_t* Gt; int ldg, gcol; float* T; bf16_t* MIX;
    __device__ __forceinline__ void operator()(Acc& acc, const Unit& u, int wr, int wc, int fr, int fq, int ui, LAS unsigned char* lds) const {
        const int row0 = u.pm * BM + wr * 64 + fr, col0 = u.pn * BM + wc * 32 + 8 * fq;
#pragma unroll
        for (int ai = 0; ai < 2; ++ai)
#pragma unroll
            for (int m = 0; m < 4; ++m) { const size_t row = (size_t)(row0 + ai * HALF + m * 16);
#pragma unroll
                for (int bj = 0; bj < 2; ++bj) { const int col = col0 + bj * HALF;
                    const u32x4 gw = *(const u32x4*)(Gt + row * ldg + gcol + col); float g[8]; unpack8(gw, g);
                    float v[8];
#pragma unroll
                    for (int e = 0; e < 4; ++e) { v[e] = acc[ai][bj][m][0][e] * sigmoidf_(g[e]); v[4 + e] = acc[ai][bj][m][1][e] * sigmoidf_(g[4 + e]); }
                    float* tp = T + row * DM + col;
                    if (STEP > 0) { const f32x4 t0 = *(const f32x4*)tp, t1 = *(const f32x4*)(tp + 4);
#pragma unroll
                        for (int e = 0; e < 4; ++e) { v[e] += t0[e]; v[4 + e] += t1[e]; } }
                    if (STEP < 2) { *(f32x4*)tp = (f32x4){v[0], v[1], v[2], v[3]}; *(f32x4*)(tp + 4) = (f32x4){v[4], v[5], v[6], v[7]}; }
                    else *(u32x4*)(MIX + row * DM + col) = pack8(v); }
                asm volatile("" ::: "memory"); }
    }
};
struct EpiResid {
    static constexpr bool PERM = false, KEEP = false;
    const float* src0; const float* src1; float* dst; long zrows;
    __device__ __forceinline__ void operator()(Acc& acc, const Unit& u, int wr, int wc, int fr, int fq, int ui, LAS unsigned char* lds) const {
        const int col0 = u.pn * BM + wc * 32 + 4 * fq; const long rbase = (long)u.z * zrows + u.pm * BM + wr * 64 + fr;
        const float* sb = (rbase >= MP && src1) ? src1 - (size_t)MP * DM : src0;
#pragma unroll
        for (int ai = 0; ai < 2; ++ai)
#pragma unroll
            for (int m = 0; m < 4; ++m) { const size_t off = (size_t)(rbase + ai * HALF + m * 16) * DM + col0;
#pragma unroll
                for (int bj = 0; bj < 2; ++bj)
#pragma unroll
                    for (int n = 0; n < 2; ++n) { const f32x4 s = *(const f32x4*)(sb + off + bj * HALF + n * 16); *(f32x4*)(dst + off + bj * HALF + n * 16) = s * DN_ALPHA + acc[ai][bj][m][n]; } }
    }
};
struct EpiSoftmax {
    static constexpr bool PERM = true, KEEP = false;
    bf16_t* O; int ldo; long zsO;
    __device__ __forceinline__ void operator()(Acc& acc, const Unit& u, int wr, int wc, int fr, int fq, int ui, LAS unsigned char* lds) const {
        LAS f32x2* tab = (LAS f32x2*)(lds + SMTAB_OFF + (ui & 1) * 8192);
        float mloc[2][4];
#pragma unroll
        for (int ai = 0; ai < 2; ++ai)
#pragma unroll
            for (int m = 0; m < 4; ++m) {
                float mx = -INFINITY;
#pragma unroll
                for (int bj = 0; bj < 2; ++bj)
#pragma unroll
                    for (int n = 0; n < 2; ++n) { const f32x4 x = acc[ai][bj][m][n]; mx = fmaxf(fmaxf(mx, fmaxf(x[0], x[1])), fmaxf(x[2], x[3])); }
                mx = fmaxf(mx, swz_xor<16>(mx)); mx = half_max(mx);
                float s = 0.f;
#pragma unroll
                for (int bj = 0; bj < 2; ++bj)
#pragma unroll
                    for (int n = 0; n < 2; ++n) { f32x4 x = acc[ai][bj][m][n]; x[0] = ex2(x[0] - mx); x[1] = ex2(x[1] - mx); x[2] = ex2(x[2] - mx); x[3] = ex2(x[3] - mx); acc[ai][bj][m][n] = x; s += (x[0] + x[1]) + (x[2] + x[3]); }
                s += swz_xor<16>(s); s = half_sum(s);
                mloc[ai][m] = mx;
                if (fq == 0) tab[(ai * HALF + wr * 64 + m * 16 + fr) * 4 + wc] = (f32x2){mx, s};
                asm volatile("" ::: "memory");
            }
        asm volatile("s_waitcnt lgkmcnt(0)" ::: "memory"); __builtin_amdgcn_s_barrier(); asm volatile("" ::: "memory");
        const int row0 = u.pm * BM + wr * 64 + fr, col0 = u.pn * BM + wc * 32 + 8 * fq;
        bf16_t* ob = O + (long)u.z * zsO;
#pragma unroll
        for (int ai = 0; ai < 2; ++ai)
#pragma unroll
            for (int m = 0; m < 4; ++m) { const int rl = ai * HALF + wr * 64 + m * 16 + fr;
                const f32x2 t0 = tab[rl * 4 + 0], t1 = tab[rl * 4 + 1], t2 = tab[rl * 4 + 2], t3 = tab[rl * 4 + 3];
                const float M = fmaxf(fmaxf(t0.x, t1.x), fmaxf(t2.x, t3.x));
                const float tot = t0.y * ex2(t0.x - M) + t1.y * ex2(t1.x - M) + t2.y * ex2(t2.x - M) + t3.y * ex2(t3.x - M);
                const float fac = ex2(mloc[ai][m] - M) / tot;
                const size_t row = (size_t)(row0 + ai * HALF + m * 16);
#pragma unroll
                for (int bj = 0; bj < 2; ++bj) { const f32x4 v0 = acc[ai][bj][m][0] * fac, v1 = acc[ai][bj][m][1] * fac;
                    u32x4 w; w.x = pk2(v0[0], v0[1]); w.y = pk2(v0[2], v0[3]); w.z = pk2(v1[0], v1[1]); w.w = pk2(v1[2], v1[3]);
                    *(u32x4*)(ob + row * ldo + col0 + bj * HALF) = w; }
                asm volatile("" ::: "memory"); }
    }
};

template <class Epi>
__device__ __forceinline__ void gemm_phase(LAS unsigned char* lds, const Gemm g, const Order& S, const Epi& E, const int wid_in) {
    int wid = wid_in; asm volatile("" : "+s"(wid));
    const int lane = fresh_lane(), tid = wid * 64 + lane;
    const int wr = wid >> 2, wc = wid & 3, fr = lane & 15, fq = lane >> 4;
    const int K = g.K, nt = K / BK;
    unsigned voffA[2], voffB[2];
#pragma unroll
    for (int i = 0; i < 2; ++i) { int R, C; stage_rc(tid * 16 + i * 8192, R, C); const int Rb = Epi::PERM ? ((R & ~31) + perm32(R & 31)) : R;
        voffA[i] = (unsigned)(R * g.lda + C) * 2u; voffB[i] = (unsigned)(Rb * g.ldb + C) * 2u; }
    const size_t kstep = (size_t)(BK * 2);
    const size_t hstepA = (size_t)HALF * g.lda * 2, hstepB = (size_t)HALF * g.ldb * 2;
    const size_t tstepA = 2 * hstepA, tstepB = 2 * hstepB;
    const int zmask = (1 << g.zshift) - 1;
    const unsigned ldsw = (unsigned)wid * 1024u;
    const int aoff = lds_byte(wr * 64 + fr, fq * 8), boff = lds_byte(wc * 32 + fr, fq * 8);
#define PG8_SA(b, h) (((b) * 2 + (h)) * HTB)
#define PG8_SB(b, h) ((4 + (b) * 2 + (h)) * HTB)
#define PG8_STAGE(bufoff, gbase, voff) do { _Pragma("unroll") for (int _i = 0; _i < 2; ++_i) \
        __builtin_amdgcn_global_load_lds((const unsigned*)((const char*)(gbase) + (voff)[_i]), (LAS unsigned*)(lds + (bufoff) + ldsw + _i * 8192), 16, 0, 0); } while (0)
#define PG8_LDA(dst, b, h) do { _Pragma("unroll") for (int m = 0; m < 4; ++m) _Pragma("unroll") for (int k = 0; k < 2; ++k) dst[m][k] = *(const LAS bf16x8*)(lds + PG8_SA(b, h) + aoff + m * 2048 + k * 1024); } while (0)
#define PG8_LDB(dst, b, h) do { _Pragma("unroll") for (int n = 0; n < 2; ++n) _Pragma("unroll") for (int k = 0; k < 2; ++k) dst[n][k] = *(const LAS bf16x8*)(lds + PG8_SB(b, h) + boff + n * 2048 + k * 1024); } while (0)
#define PG8_MMA(ai, bj, At, Bt) do { __builtin_amdgcn_s_setprio(1); _Pragma("unroll") for (int m = 0; m < 4; ++m) _Pragma("unroll") for (int n = 0; n < 2; ++n) _Pragma("unroll") for (int k = 0; k < 2; ++k) \
        acc[ai][bj][m][n] = __builtin_amdgcn_mfma_f32_16x16x32_bf16(Bt[n][k], At[m][k], acc[ai][bj][m][n], 0, 0, 0); __builtin_amdgcn_s_setprio(0); } while (0)
#define PG8_WAIT_V(n) asm volatile("s_waitcnt vmcnt(" #n ")" ::: "memory")
#define PG8_WAIT_L(n) asm volatile("s_waitcnt lgkmcnt(" #n ")" ::: "memory")
#define PG8_BAR __builtin_amdgcn_s_barrier()
#define PG8_SCHED __builtin_amdgcn_sched_barrier(0)
#define PG8_ABASE(u) ((const char*)g.A + ((size_t)((u).z >> g.zshift) * g.zsA1 + (size_t)((u).z & zmask) * g.zsA0) * 2 + (size_t)(u).pm * tstepA)
#define PG8_BBASE(u) ((const char*)g.Bt + ((size_t)((u).z >> g.zshift) * g.zsB1 + (size_t)((u).z & zmask) * g.zsB0) * 2 + (size_t)(u).pn * tstepB)
    Unit cur, nxt; int ui = 0;
    if (!S.next(0, cur)) return;
    Acc acc;
#pragma unroll
    for (int a = 0; a < 2; ++a)
#pragma unroll
        for (int b = 0; b < 2; ++b)
#pragma unroll
            for (int m = 0; m < 4; ++m)
#pragma unroll
                for (int n = 0; n < 2; ++n) acc[a][b][m][n] = (f32x4){0.f, 0.f, 0.f, 0.f};
    bf16x8 At[4][2], B0[2][2], B1[2][2];
    const char* cA = PG8_ABASE(cur); const char* cB = PG8_BBASE(cur);
    PG8_STAGE(PG8_SB(0, 0), cB, voffB); PG8_STAGE(PG8_SB(0, 1), cB + hstepB, voffB); PG8_STAGE(PG8_SA(0, 0), cA, voffA); PG8_STAGE(PG8_SA(0, 1), cA + hstepA, voffA);
    if (wr == 1) PG8_BAR;
    PG8_WAIT_V(2); PG8_BAR;
    PG8_STAGE(PG8_SB(1, 0), cB + kstep, voffB); PG8_STAGE(PG8_SA(1, 0), cA + kstep, voffA); PG8_STAGE(PG8_SB(1, 1), cB + hstepB + kstep, voffB);
    PG8_WAIT_V(6); PG8_BAR;
    for (;;) {
        const bool has_next = S.next(ui + 1, nxt);
        const char* nA = has_next ? PG8_ABASE(nxt) : cA; const char* nB = has_next ? PG8_BBASE(nxt) : cB;
        for (int t = 0; t < nt; t += 2) {
            const bool last = (t == nt - 2);
            const char* a1 = cA + (size_t)(t + 1) * kstep;
            const char* a2 = last ? nA : cA + (size_t)(t + 2) * kstep; const char* b2 = last ? nB : cB + (size_t)(t + 2) * kstep;
            const char* a3 = a2 + kstep; const char* b3 = b2 + kstep;
            PG8_LDB(B0, 0, 0); PG8_LDB(B1, 0, 1); PG8_SCHED; PG8_LDA(At, 0, 0); PG8_STAGE(PG8_SA(1, 1), a1 + hstepA, voffA);
            PG8_WAIT_V(8); PG8_WAIT_L(0); PG8_BAR; PG8_MMA(0, 0, At, B0); PG8_MMA(0, 1, At, B1); PG8_BAR; PG8_SCHED;
            PG8_LDA(At, 0, 1); PG8_STAGE(PG8_SB(0, 0), b2, voffB); PG8_STAGE(PG8_SB(0, 1), b2 + hstepB, voffB); PG8_STAGE(PG8_SA(0, 0), a2, voffA);
            PG8_WAIT_V(8); PG8_WAIT_L(0); PG8_BAR; PG8_MMA(1, 0, At, B0); PG8_MMA(1, 1, At, B1); PG8_BAR; PG8_SCHED;
            PG8_LDB(B0, 1, 0); PG8_LDB(B1, 1, 1); PG8_SCHED; PG8_LDA(At, 1, 0); PG8_STAGE(PG8_SA(0, 1), a2 + hstepA, voffA);
            PG8_WAIT_V(8); PG8_WAIT_L(0); PG8_BAR; PG8_MMA(0, 0, At, B0); PG8_MMA(0, 1, At, B1); PG8_BAR; PG8_SCHED;
            PG8_LDA(At, 1, 1); PG8_STAGE(PG8_SB(1, 0), b3, voffB); PG8_STAGE(PG8_SB(1, 1), b3 + hstepB, voffB); PG8_STAGE(PG8_SA(1, 0), a3, voffA);
            PG8_WAIT_V(8); PG8_WAIT_L(0); PG8_BAR; PG8_MMA(1, 0, At, B0); PG8_MMA(1, 1, At, B1); PG8_BAR; PG8_SCHED;
        }
        if (wr == 0) PG8_BAR;
        E(acc, cur, wr, wc, fr, fq, ui, lds);
        if (!has_next) break;
        bool keep = false;
        if constexpr (Epi::KEEP) keep = E.keep(cur);
        if (!keep) {
#pragma unroll
        for (int a = 0; a < 2; ++a)
#pragma unroll
            for (int b = 0; b < 2; ++b)
#pragma unroll
                for (int m = 0; m < 4; ++m)
#pragma unroll
                    for (int n = 0; n < 2; ++n) acc[a][b][m][n] = (f32x4){0.f, 0.f, 0.f, 0.f};
        }
        cur = nxt; cA = nA; cB = nB; ++ui;
        if (wr == 1) PG8_BAR;
    }
    PG8_WAIT_V(0);
    PG8_BAR;
#undef PG8_SA
#undef PG8_SB
#undef PG8_STAGE
#undef PG8_LDA
#undef PG8_LDB
#undef PG8_MMA
#undef PG8_WAIT_V
#undef PG8_WAIT_L
#undef PG8_BAR
#undef PG8_SCHED
#undef PG8_ABASE
#undef PG8_BBASE
}
}

#define XB_TMO      128
#define XB_XCNT(j)  (256  + 64 * (j))
#define XB_XSUB(j)  (1280 + 64 * (j))
#define XB_XGEN(j)  (2304 + 64 * (j))
#define XB_TOP      3328
#define XB_TOPGEN   3392
#define XCD_BAR_WORDS 3456
#define XB_SPIN_CAP (1u << 18)
__device__ __forceinline__ unsigned xb_ld(unsigned* p)              { return __hip_atomic_load(p, __ATOMIC_RELAXED, __HIP_MEMORY_SCOPE_AGENT); }
__device__ __forceinline__ unsigned xb_add(unsigned* p, unsigned v) { return __hip_atomic_fetch_add(p, v, __ATOMIC_RELAXED, __HIP_MEMORY_SCOPE_AGENT); }
__device__ __forceinline__ unsigned xb_xcc_id() { return (unsigned)__builtin_amdgcn_s_getreg((3 << 11) | 20) & 0xFu; }
#define XB_SPIN(cond, bar) do { unsigned _sp = 0; while (cond) { __builtin_amdgcn_s_sleep(1); \
    if ((++_sp & 255u) == 0u) { if (xb_ld(&(bar)[XB_TMO])) break; if (_sp > XB_SPIN_CAP) { atomicAdd(&(bar)[XB_TMO], 1u); break; } } } } while (0)
struct XcdBarrier { unsigned* bar; unsigned x; volatile LAS unsigned* st; };
__device__ __forceinline__ XcdBarrier xcd_barrier_post(unsigned* bar, volatile LAS unsigned* st) {
    XcdBarrier b; b.bar = bar; b.x = xb_xcc_id(); b.st = st;
    if (threadIdx.x == 0) (void)xb_add(&bar[XB_XCNT(b.x)], 1u);
    return b;
}
__device__ __forceinline__ void xcd_barrier_complete(unsigned* bar, unsigned x, unsigned& nloc, unsigned& nx) {
    const unsigned G = gridDim.x * gridDim.y * gridDim.z;
    unsigned sum, cnt, mine, sp = 0u;
    for (;;) {
        sum = 0u; cnt = 0u; mine = 0u;
#pragma unroll
        for (unsigned j = 0; j < 16; ++j) { const unsigned c = xb_ld(&bar[XB_XCNT(j)]); sum += c; cnt += (c > 0u) ? 1u : 0u; mine = (j == x) ? c : mine; }
        if (sum == G) break;
        __builtin_amdgcn_s_sleep(1);
        if ((++sp & 255u) == 0u) { if (xb_ld(&bar[XB_TMO])) break; if (sp > XB_SPIN_CAP) { atomicAdd(&bar[XB_TMO], 1u); break; } }
    }
    nloc = mine > 0u ? mine : 1u; nx = cnt > 0u ? cnt : 1u;
}
__device__ __forceinline__ void xcd_barrier(const XcdBarrier& b, const int wid) {
    asm volatile("s_waitcnt vmcnt(0)" ::: "memory");
    __syncthreads();
    if (wid == 0 && fresh_lane() == 0) {
        unsigned* bar = b.bar;
        __builtin_amdgcn_s_waitcnt(0);
        unsigned nloc = b.st[0], nx = b.st[1];
        if (nloc == 0u) { xcd_barrier_complete(bar, b.x, nloc, nx); b.st[0] = nloc; b.st[1] = nx; }
        const unsigned old = xb_add(&bar[XB_XSUB(b.x)], 1u);
        const unsigned gen = old / nloc;
        if (old + 1u == (gen + 1u) * nloc) {
            __builtin_amdgcn_fence(__ATOMIC_RELEASE, "agent");
            asm volatile("s_waitcnt vmcnt(0)" ::: "memory");
            const unsigned og = xb_add(&bar[XB_TOP], 1u);
            const unsigned tg = og / nx;
            if (og + 1u == (tg + 1u) * nx) xb_add(&bar[XB_TOPGEN], 1u);
            else XB_SPIN(xb_ld(&bar[XB_TOPGEN]) == tg, bar);
            __builtin_amdgcn_fence(__ATOMIC_ACQUIRE, "agent");
            xb_add(&bar[XB_XGEN(b.x)], 1u);
            asm volatile("s_waitcnt vmcnt(0)" ::: "memory");
        } else {
            XB_SPIN(xb_ld(&bar[XB_XGEN(b.x)]) == gen, bar);
            __builtin_amdgcn_fence(__ATOMIC_ACQUIRE, "agent");
            asm volatile("s_waitcnt vmcnt(0)" ::: "memory");
        }
    }
    __syncthreads();
}

__device__ __forceinline__ void transpose_item(const float* W, int N, bf16_t* WT, int ldw, int koff, LAS float* scr, int item, int lane) {
    const int nblk = N / 32, kb = item / nblk, nb = item % nblk, k0 = 64 * kb, n0 = 32 * nb;
#pragma unroll 8
    for (int i = 0; i < 32; ++i) { const int kk = 2 * i + (lane >> 5); scr[kk * 33 + (lane & 31)] = W[(size_t)(k0 + kk) * N + n0 + (lane & 31)]; }
    LDS_WAIT(); asm volatile("" ::: "memory");
    const int c = lane & 7;
#pragma unroll
    for (int j = 0; j < 4; ++j) { const int n = (lane >> 3) + 8 * j; const LAS float* s = scr + (8 * c) * 33 + n;
        u32x4 o; o.x = pk2(s[0 * 33], s[1 * 33]); o.y = pk2(s[2 * 33], s[3 * 33]); o.z = pk2(s[4 * 33], s[5 * 33]); o.w = pk2(s[6 * 33], s[7 * 33]);
        *(u32x4*)(WT + (size_t)(n0 + n) * ldw + koff + k0 + 8 * c) = o; }
    LDS_WAIT(); asm volatile("" ::: "memory");
}
__device__ __forceinline__ void cvt_plain(const float* src, bf16_t* dst, size_t n8, int gtid, int gthreads) {
    for (size_t i = gtid; i < n8; i += gthreads) { const f32x4 a = *(const f32x4*)(src + i * 8), b = *(const f32x4*)(src + i * 8 + 4);
        u32x4 w; w.x = pk2(a[0], a[1]); w.y = pk2(a[2], a[3]); w.z = pk2(b[0], b[1]); w.w = pk2(b[2], b[3]); *(u32x4*)(dst + i * 8) = w; }
}
__device__ __forceinline__ int t5_bucket(int rel) {
    const int n = rel < 0 ? -rel : rel; int b;
    if (n < 8) b = n; else if (n < 12) b = 8; else if (n < 16) b = 9; else if (n < 23) b = 10; else if (n < 32) b = 11; else if (n < 46) b = 12; else if (n < 64) b = 13; else if (n < 91) b = 14; else b = 15;
    return (rel > 0 ? 16 : 0) + b;
}

typedef short v4i16_t __attribute__((ext_vector_type(4)));
__device__ __forceinline__ s16x4 vtr(const LAS unsigned char* p) { return __builtin_bit_cast(s16x4, __builtin_amdgcn_ds_read_tr16_b64_v4i16((LAS v4i16_t*)p)); }
template <int PITCH, bool PERMUTED> __device__ __forceinline__ int tr_lane_off(int lane) {
    const int hi = lane >> 5, blk = (lane >> 4) & 1, q = (lane & 15) >> 2, p = lane & 3;
    return ((PERMUTED ? 4 * hi : 8 * hi) + q) * PITCH + (16 * blk + 4 * p) * 2;
}
template <int PITCH, bool PERMUTED> __device__ __forceinline__ bf16x8 tr_frag(const LAS unsigned char* tile_lane  , int row0, int col0) {
    const s16x4 a = vtr(tile_lane + row0 * PITCH + col0 * 2), b = vtr(tile_lane + (row0 + (PERMUTED ? 8 : 4)) * PITCH + col0 * 2);
    return (bf16x8){a[0], a[1], a[2], a[3], b[0], b[1], b[2], b[3]};
}
__device__ __forceinline__ int crow(int r) { return (r & 3) + 8 * (r >> 2); }
__device__ __forceinline__ bf16x8 pack_frag(const f32x16& p, int base) {
    u32x4 w; w.x = pk2(p[base], p[base + 1]); w.y = pk2(p[base + 2], p[base + 3]); w.z = pk2(p[base + 4], p[base + 5]); w.w = pk2(p[base + 6], p[base + 7]);
    return __builtin_bit_cast(bf16x8, w);
}
__device__ __forceinline__ bf16x8 ldg_frag_bf16(const bf16_t* p) { return __builtin_bit_cast(bf16x8, *(const u32x4*)p); }
__device__ __forceinline__ bf16x8 ldg_frag_f32(const float* p) { const f32x4 a = *(const f32x4*)p, b = *(const f32x4*)(p + 4);
    u32x4 w; w.x = pk2(a[0], a[1]); w.y = pk2(a[2], a[3]); w.z = pk2(b[0], b[1]); w.w = pk2(b[2], b[3]); return __builtin_bit_cast(bf16x8, w); }

struct AttnSrc { const void* k0; const void* v0; int pitch0; int f32src; int nt0; int kpos0; const bf16_t* k1; const bf16_t* v1; int pitch1; int nvalid1; int kpos1; };
template <bool SINK, bool F32SRC>
__device__ __forceinline__ void attn_item(const bf16_t* qrow, const LAS float* lut, int lutidx, float sink_l2, const AttnSrc& S,
                                          bf16_t* orow, bool ovalid, LAS unsigned char* vt, int lane) {
    constexpr int VP = 144;
    const int r32 = lane & 31, hi = lane >> 5;
    const float qscale = 0.125f * LOG2E;
    bf16x8 qf[4];
#pragma unroll
    for (int d0 = 0; d0 < 4; ++d0) { float f[8]; unpack8(*(const u32x4*)(qrow + 16 * d0 + 8 * hi), f);
#pragma unroll
        for (int e = 0; e < 8; ++e) f[e] *= qscale;
        qf[d0] = __builtin_bit_cast(bf16x8, pack8(f)); }
    f32x16 o0, o1;
#pragma unroll
    for (int r = 0; r < 16; ++r) { o0[r] = 0.f; o1[r] = 0.f; }
    float m = SINK ? sink_l2 : -1e30f, l = (SINK && hi == 0) ? 1.f : 0.f;
    const LAS unsigned char* vtl = vt + tr_lane_off<VP, true>(lane);
    const int nt = S.nt0 + (S.k1 ? 1 : 0);
    for (int t = 0; t < nt; ++t) {
        const bool part = t >= S.nt0;
        const int nvalid = part ? S.nvalid1 : 64, kpos = part ? S.kpos1 : S.kpos0 + 64 * t;
        const bool f32s = F32SRC && !part;
        const int pitch = part ? S.pitch1 : S.pitch0;
        const char* kb = part ? (const char*)S.k1 : (const char*)S.k0 + (size_t)t * 64 * pitch * (F32SRC ? 4 : 2);
        const char* vb = part ? (const char*)S.v1 : (const char*)S.v0 + (size_t)t * 64 * pitch * (F32SRC ? 4 : 2);
#pragma unroll
        for (int i = 0; i < 8; ++i) { int row = 8 * i + (lane >> 3); const int ch = lane & 7; const int rsrc = row < nvalid ? row : nvalid - 1;
            u32x4 w;
            if (f32s) w = __builtin_bit_cast(u32x4, ldg_frag_f32((const float*)vb + (size_t)rsrc * pitch + ch * 8));
            else w = *(const u32x4*)((const bf16_t*)vb + (size_t)rsrc * pitch + ch * 8);
            *(LAS u32x4*)(vt + row * VP + ch * 16) = w;
            if ((i & 3) == 3) asm volatile("" ::: "memory"); }
        f32x16 p0, p1;
#pragma unroll
        for (int r = 0; r < 16; ++r) { p0[r] = 0.f; p1[r] = 0.f; }
        const int ra = r32 < nvalid ? r32 : nvalid - 1, rb = (r32 + 32) < nvalid ? r32 + 32 : nvalid - 1;
#pragma unroll
        for (int d0 = 0; d0 < 4; ++d0) {
            bf16x8 ka, kc;
            if (f32s) { ka = ldg_frag_f32((const float*)kb + (size_t)ra * pitch + 16 * d0 + 8 * hi); kc = ldg_frag_f32((const float*)kb + (size_t)rb * pitch + 16 * d0 + 8 * hi); }
            else { ka = ldg_frag_bf16((const bf16_t*)kb + (size_t)ra * pitch + 16 * d0 + 8 * hi); kc = ldg_frag_bf16((const bf16_t*)kb + (size_t)rb * pitch + 16 * d0 + 8 * hi); }
            p0 = __builtin_amdgcn_mfma_f32_32x32x16_bf16(ka, qf[d0], p0, 0, 0, 0);
            p1 = __builtin_amdgcn_mfma_f32_32x32x16_bf16(kc, qf[d0], p1, 0, 0, 0);
        }
        const int li = lutidx + kpos;
#pragma unroll
        for (int r = 0; r < 16; ++r) { p0[r] += lut[li + crow(r)]; p1[r] += lut[li + 32 + crow(r)]; }
        if (part) {
#pragma unroll
            for (int r = 0; r < 16; ++r) { const int kv = crow(r) + 4 * hi; if (kv >= nvalid) p0[r] = -INFINITY; if (kv + 32 >= nvalid) p1[r] = -INFINITY; }
        }
        float mx = fmaxf(p0[0], p1[0]);
#pragma unroll
        for (int r = 1; r < 16; ++r) mx = fmaxf(mx, fmaxf(p0[r], p1[r]));
        mx = half_max(mx);
        const float mn = fmaxf(m, mx), f = ex2(m - mn);
        m = mn; l *= f;
        float rs = 0.f;
#pragma unroll
        for (int r = 0; r < 16; ++r) { o0[r] *= f; o1[r] *= f; p0[r] = ex2(p0[r] - m); p1[r] = ex2(p1[r] - m); rs += p0[r] + p1[r]; }
        l += rs;
#pragma unroll
        for (int s4 = 0; s4 < 4; ++s4) {
            const bf16x8 pf = (s4 < 2) ? pack_frag(p0, 8 * (s4 & 1)) : pack_frag(p1, 8 * (s4 & 1));
            const bf16x8 v0 = tr_frag<VP, true>(vtl, 16 * s4, 0), v1 = tr_frag<VP, true>(vtl, 16 * s4, 32);
            o0 = __builtin_amdgcn_mfma_f32_32x32x16_bf16(v0, pf, o0, 0, 0, 0);
            o1 = __builtin_amdgcn_mfma_f32_32x32x16_bf16(v1, pf, o1, 0, 0, 0);
        }
    }
    l = half_sum(l);
    const float inv = 1.f / l;
    if (ovalid) {
#pragma unroll
        for (int rg = 0; rg < 4; ++rg) {
            u32x2 w0, w1; w0.x = pk2(o0[4 * rg] * inv, o0[4 * rg + 1] * inv); w0.y = pk2(o0[4 * rg + 2] * inv, o0[4 * rg + 3] * inv);
            w1.x = pk2(o1[4 * rg] * inv, o1[4 * rg + 1] * inv); w1.y = pk2(o1[4 * rg + 2] * inv, o1[4 * rg + 3] * inv);
            *(u32x2*)(orow + 8 * rg + 4 * hi) = w0; *(u32x2*)(orow + 32 + 8 * rg + 4 * hi) = w1; }
    }
}


template <int MODE>
__device__ __forceinline__ void sgemm_phase(LAS unsigned char* lds, const int wave, const int vcu, const int G,
                                            const bf16_t* A0, const int lda, const bf16_t* Bt0, const int ldb, const int K, const int nseg, const int segstep,
                                            const float* src, float* dst, bf16_t* O, const int ldo, const bf16_t* Gt, const int ldg) {
    for (int u = vcu; u < 256; u += G) {
        const int lane = fresh_lane(), r32 = lane & 31, hi = lane >> 5, tid = wave * 64 + lane;
        const int row0 = (u >> 5) * 32, col0 = (u & 31) * 64;
        const int kw = K >> 3;
        float tot[4] = {0.f, 0.f, 0.f, 0.f};
        LAS float* part = (LAS float*)lds;
        for (int seg = 0; seg < nseg; ++seg) {
            const bf16_t* Ap = A0 + (size_t)seg * segstep + (size_t)(row0 + r32) * lda + wave * kw + 8 * hi;
            const bf16_t* Bp = Bt0 + (size_t)seg * segstep + (size_t)(col0 + r32) * ldb + wave * kw + 8 * hi;
            const bf16_t* Bq = Bp + (size_t)32 * ldb;
            f32x16 acc0, acc1;
#pragma unroll
            for (int r = 0; r < 16; ++r) { acc0[r] = 0.f; acc1[r] = 0.f; }
            bf16x8 a[4], b0[4], b1[4], an[4], bn0[4], bn1[4];
#pragma unroll
            for (int i = 0; i < 4; ++i) { a[i] = ldg_frag_bf16(Ap + 16 * i); b0[i] = ldg_frag_bf16(Bp + 16 * i); b1[i] = ldg_frag_bf16(Bq + 16 * i); }
            for (int k = 0; k < kw; k += 64) {
                const int kn = (k + 64 < kw) ? k + 64 : k;
#pragma unroll
                for (int i = 0; i < 4; ++i) { an[i] = ldg_frag_bf16(Ap + kn + 16 * i); bn0[i] = ldg_frag_bf16(Bp + kn + 16 * i); bn1[i] = ldg_frag_bf16(Bq + kn + 16 * i); }
#pragma unroll
                for (int i = 0; i < 4; ++i) { acc0 = __builtin_amdgcn_mfma_f32_32x32x16_bf16(a[i], b0[i], acc0, 0, 0, 0); acc1 = __builtin_amdgcn_mfma_f32_32x32x16_bf16(a[i], b1[i], acc1, 0, 0, 0); }
#pragma unroll
                for (int i = 0; i < 4; ++i) { a[i] = an[i]; b0[i] = bn0[i]; b1[i] = bn1[i]; }
            }
#pragma unroll
            for (int r = 0; r < 16; ++r) { part[((wave * 2 + 0) * 16 + r) * 64 + lane] = acc0[r]; part[((wave * 2 + 1) * 16 + r) * 64 + lane] = acc1[r]; }
            __syncthreads();
#pragma unroll
            for (int j = 0; j < 4; ++j) { const int e = tid + 512 * j; float v = 0.f;
#pragma unroll
                for (int w = 0; w < 8; ++w) v += part[w * 2048 + e];
                const int c = e >> 10, reg = (e >> 6) & 15, ln = e & 63; const int m = row0 + crow(reg) + 4 * (ln >> 5), n = col0 + 32 * c + (ln & 31);
                if (MODE == 0) dst[(size_t)m * DM + n] = DN_ALPHA * src[(size_t)m * DM + n] + v;
                else if (MODE == 1) O[(size_t)m * ldo + n] = f2bf(v);
                else { tot[j] += sigmoidf_(bf2f(Gt[(size_t)m * ldg + seg * 2048 + n])) * v; if (seg == nseg - 1) O[(size_t)m * ldo + n] = f2bf(tot[j]); } }
            __syncthreads();
        }
    }
}

struct Args { const float* in[33]; float* out; unsigned char* ws; int ph_lo, ph_hi; };
constexpr int NPHASE = 31;

__global__ void __launch_bounds__(512, 2) enc_fwd(Args args) {
    extern __shared__ __attribute__((aligned(16))) unsigned char lds_raw[];
    LAS unsigned char* lds = (LAS unsigned char*)lds_raw;
    volatile LAS unsigned* MISC = (volatile LAS unsigned*)(lds + MISC_OFF);
    const int tid0 = threadIdx.x, wave = __builtin_amdgcn_readfirstlane(tid0 >> 6);
    const int G = gridDim.x, bx = blockIdx.x;
    const int vcu = (G % 8 == 0) ? (bx % 8) * (G / 8) + bx / 8 : bx;
    const int gw0 = vcu * 8 + wave, NGW = G * 8;
    const int gthreads = NGW * 64;
    unsigned char* ws = args.ws;
    float* dout = args.out;
    for (int u = tid0; u < (LDS_BYTES - MISC_OFF) / 4; u += 512) ((LAS unsigned*)(lds + MISC_OFF))[u] = 0u;
    __syncthreads();
    XcdBarrier bar; bar.bar = (unsigned*)(ws + WS_CTL) + 4096; bar.x = 0; bar.st = nullptr;
    if (N_LAUNCH_MODE == 0) bar = xcd_barrier_post((unsigned*)(ws + WS_CTL) + 4096, MISC + 8);
    const int lo = args.ph_lo, hi = args.ph_hi;
#ifndef PHASE_MASK
#define PHASE_MASK 0xFFFFu
#endif
#define PH_EN(j) (((PHASE_MASK) >> (j)) & 1u)
#define IN(k) (lo <= (k) && (k) < hi)
#if defined(PROBE_MASK)
    unsigned long long pr_prev = __builtin_amdgcn_s_memrealtime(), pr_acc = 0ull;
#define PR_STAMP(j) do { const unsigned long long t_ = __builtin_amdgcn_s_memrealtime(); if (((PROBE_MASK) >> (j)) & 1u) pr_acc += t_ - pr_prev; pr_prev = t_; } while (0)
#else
#define PR_STAMP(j) do { } while (0)
#endif
#define SEAM(k) do { if (IN(k) && IN((k) + 1)) xcd_barrier(bar, wave); PR_STAMP(((k) == 0) ? 15 : ((k) - 1) % 15); } while (0)

    bf16_t* const XB = (bf16_t*)(ws + WS_XB); float* const X = (float*)(ws + WS_X);
    bf16_t* const P = (bf16_t*)(ws + WS_R1); bf16_t* const U = (bf16_t*)(ws + WS_R1);
    bf16_t* const OB = (bf16_t*)(ws + WS_OB); float* const TMP = (float*)(ws + WS_TMP); bf16_t* const MIX = (bf16_t*)(ws + WS_MIX);
    bf16_t* const H = (bf16_t*)(ws + WS_H); float* const UPD = (float*)(ws + WS_UPD); bf16_t* const S0T = (bf16_t*)(ws + WS_S0T);
    bf16_t* const MEMB = (bf16_t*)(ws + WS_MEMB); bf16_t* const PM = (bf16_t*)(ws + WS_PM);
    bf16_t* const QM = (bf16_t*)(ws + WS_QM); bf16_t* const OM = (bf16_t*)(ws + WS_OM);
    const float* const ROPE = (const float*)(ws + WS_ROPE);
    float* const LUTA = (float*)(ws + WS_LUT); float* const LUTC = LUTA + 16 * 256;

    if (PH_EN(15) && IN(0)) { const int tid = wave * 64 + fresh_lane(); int gw = gw0; asm volatile("" : "+s"(gw)); const int lane = tid & 63; const int gtid = gw * 64 + lane; (void)gtid; (void)lane;
        LAS float* scr = (LAS float*)(lds + wave * 16384);
        constexpr int I_IN = 32 * 424, I_BR = 16 * 64, I_SQ = 32 * 64, I_FIN = 32 * 352, I_FOUT = 88 * 64;
        constexpr int PER_L = I_IN + 3 * I_BR + 5 * I_SQ + I_FIN + I_FOUT;
        for (int it = gw; it < 2 * PER_L; it += NGW) {
            const int l = it / PER_L; int r = it - l * PER_L;
            if (r < I_IN) { transpose_item(args.in[11] + (size_t)l * DM * NIN, NIN, (bf16_t*)(ws + W_IN) + (size_t)l * NIN * DM, DM, 0, scr, r, lane); continue; } r -= I_IN;
            if (r < 3 * I_BR) { const int w = r / I_BR; transpose_item(args.in[15 + w] + (size_t)l * 1024 * DM, DM, (bf16_t*)(ws + W_BR) + (size_t)l * DM * 3072, 3072, 1024 * w, scr, r - w * I_BR, lane); continue; } r -= 3 * I_BR;
            if (r < 5 * I_SQ) { const int w = r / I_SQ; const int src = (w == 0) ? 18 : 20 + w;
                const size_t dsto = (w == 0) ? W_MIXO : (w == 1) ? W_MQT : (w == 2) ? W_MKT : (w == 3) ? W_MVT : W_MOT;
                transpose_item(args.in[src] + (size_t)l * DM * DM, DM, (bf16_t*)(ws + dsto) + (size_t)l * DM * DM, DM, 0, scr, r - w * I_SQ, lane); continue; } r -= 5 * I_SQ;
            if (r < I_FIN) { transpose_item(args.in[27] + (size_t)l * DM * FF2, FF2, (bf16_t*)(ws + W_FIN) + (size_t)l * FF2 * DM, DM, 0, scr, r, lane); continue; } r -= I_FIN;
            transpose_item(args.in[30] + (size_t)l * FF * DM, DM, (bf16_t*)(ws + W_FOUT) + (size_t)l * DM * FF, FF, 0, scr, r, lane);
        }
        cvt_plain(args.in[21], (bf16_t*)(ws + W_MQN), (size_t)2 * DM * DM / 8, gtid, gthreads);
        cvt_plain(args.in[0], XB, (size_t)MP * DM / 8, gtid, gthreads);
        cvt_plain(args.in[1], XB + (size_t)MP * DM, (size_t)MS * DM / 8, gtid, gthreads);
        cvt_plain(args.in[2], MEMB, (size_t)512 * DM / 8, gtid, gthreads);
        for (int i = gtid; i < 4096 * 32; i += gthreads) { const int pos = i >> 5, d = i & 31;
            const float inv = exp2f(-(float)d * (13.287712379549449f / 32.f));
            const float ang = (float)pos * inv;
            const double rev = (double)ang * 0.15915494309189535; const float fr = (float)(rev - rint(rev));
            ((float*)(ws + WS_ROPE))[pos * 64 + d] = __builtin_amdgcn_cosf(fr); ((float*)(ws + WS_ROPE))[pos * 64 + 32 + d] = __builtin_amdgcn_sinf(fr); }
        for (int i = gtid; i < 16 * 256; i += gthreads) { const int h = i >> 8, rel = (i & 255) - 191; LUTA[i] = (rel <= 64) ? args.in[12][t5_bucket(rel) * 16 + h] * LOG2E : 0.f; }
        for (int i = gtid; i < 2 * 16 * 640; i += gthreads) { const int lh = i / 640, rel = (i % 640) - 575; int c = rel < -256 ? -256 : (rel > 256 ? 256 : rel);
            LUTC[i] = args.in[14][(size_t)lh * 513 + c + 256] * LOG2E; }
    }
    SEAM(0);

    for (int l = 0; l < 2; ++l) {
        const int pb = 1 + 15 * l;
        if (hi <= pb || lo >= pb + 15) continue;
        int bxl = blockIdx.x; asm volatile("" : "+s"(bxl));
        unsigned char* wsl = args.ws; asm volatile("" : "+s"(wsl));
        bf16_t* const XB = (bf16_t*)(wsl + WS_XB); float* const X = (float*)(wsl + WS_X);
        bf16_t* const P = (bf16_t*)(wsl + WS_R1); bf16_t* const U = (bf16_t*)(wsl + WS_R1);
        bf16_t* const OB = (bf16_t*)(wsl + WS_OB); float* const TMP = (float*)(wsl + WS_TMP); bf16_t* const MIX = (bf16_t*)(wsl + WS_MIX);
        bf16_t* const H = (bf16_t*)(wsl + WS_H); float* const UPD = (float*)(wsl + WS_UPD); bf16_t* const S0T = (bf16_t*)(wsl + WS_S0T);
        bf16_t* const MEMB = (bf16_t*)(wsl + WS_MEMB); bf16_t* const PM = (bf16_t*)(wsl + WS_PM);
        bf16_t* const QM = (bf16_t*)(wsl + WS_QM); bf16_t* const OM = (bf16_t*)(wsl + WS_OM);
        const float* const ROPE = (const float*)(wsl + WS_ROPE);
        float* const LUTA = (float*)(wsl + WS_LUT); float* const LUTC = LUTA + 16 * 256;
        const bf16_t* WinT = (const bf16_t*)(wsl + W_IN) + (size_t)l * NIN * DM;
        const bf16_t* WbrT = (const bf16_t*)(wsl + W_BR) + (size_t)l * DM * 3072;
        const bf16_t* WmixoT = (const bf16_t*)(wsl + W_MIXO) + (size_t)l * DM * DM;
        const bf16_t* WmqN = (const bf16_t*)(wsl + W_MQN) + (size_t)l * DM * DM;
        const bf16_t* WmqT = (const bf16_t*)(wsl + W_MQT) + (size_t)l * DM * DM;
        const bf16_t* WmkT = (const bf16_t*)(wsl + W_MKT) + (size_t)l * DM * DM;
        const bf16_t* WmvT = (const bf16_t*)(wsl + W_MVT) + (size_t)l * DM * DM;
        const bf16_t* WmoT = (const bf16_t*)(wsl + W_MOT) + (size_t)l * DM * DM;
        const bf16_t* WfinT = (const bf16_t*)(wsl + W_FIN) + (size_t)l * FF2 * DM;
        const bf16_t* WfoutT = (const bf16_t*)(wsl + W_FOUT) + (size_t)l * DM * FF;
        bf16_t* MKB = (bf16_t*)(wsl + WS_MKB) + (size_t)l * 512 * DM; bf16_t* MVB = (bf16_t*)(wsl + WS_MVB) + (size_t)l * 512 * DM;
        bf16_t* MBT = (bf16_t*)(wsl + WS_MBT) + (size_t)l * 2 * 1024 * DM; bf16_t* NBT = (bf16_t*)(wsl + WS_NBT) + (size_t)l * 2 * DM * 1024;

        if (PH_EN(0) && IN(pb + 0)) { const int tid = wave * 64 + fresh_lane(); int gw = gw0; asm volatile("" : "+s"(gw)); const int lane = tid & 63; const int gtid = gw * 64 + lane; (void)gtid; (void)lane;
            { pg8::Gemm g{XB, WinT, DM, DM, DM, 0, 0, 0, 0, 0}; pg8::Order S; S.init(33, 53, 1, G, bxl);
              pg8::EpiOut E{P, NIN, 0, 0, nullptr, 0, 0, 1.f, 0};
              pg8::gemm_phase<pg8::EpiOut>(lds, g, S, E, wave); }
            {
              pg8::Gemm g{MEMB, WmkT, DM, DM, DM, 0, 0, (long)2 * DM * DM, 0, 0}; pg8::Order S; S.init(2, 8, 2, G, G - 1 - bxl);
              pg8::EpiOut E{MKB, DM, (long)2 * 512 * DM, 0, dout + O_MKP + (size_t)l * 512 * DM, DM, (long)(O_MVP - O_MKP), 1.f, 0};
              pg8::gemm_phase<pg8::EpiOut>(lds, g, S, E, wave); }
        }
        SEAM(pb + 0);

        if (PH_EN(1) && IN(pb + 1)) { const int tid = wave * 64 + fresh_lane(); int gw = gw0; asm volatile("" : "+s"(gw)); const int lane = tid & 63; const int gtid = gw * 64 + lane; (void)gtid; (void)lane;
            for (int it = gw; it < 1024; it += NGW) {
                const int lane = fresh_lane();
                const int n = it & 63, h = (it >> 6) & 7, b = it >> 9;
                const float lg = log2f(1.f - exp2f(-5.f - (float)h));
                LAS unsigned char* kt = lds + wave * WREG; LAS unsigned char* vtile = kt + 9216;
                const size_t R0 = (size_t)b * SEQ + 64 * n;
#pragma unroll
                for (int t = 0; t < 4; ++t) { const int idx = lane + 64 * t, tok = idx >> 2, c = idx & 3; const int pos = 64 * n + tok;
                    bf16_t* qp = P + (R0 + tok) * NIN + C_QB + 64 * h + 8 * c; bf16_t* kp = P + (R0 + tok) * NIN + C_KB + 64 * h + 8 * c;
                    float q1[8], q2[8], k1[8], k2[8], cs[8], sn[8];
                    unpack8(*(const u32x4*)qp, q1); unpack8(*(const u32x4*)(qp + 32), q2); unpack8(*(const u32x4*)kp, k1); unpack8(*(const u32x4*)(kp + 32), k2);
                    const float* rp = ROPE + pos * 64 + 8 * c;
                    *(f32x4*)&cs[0] = *(const f32x4*)rp; *(f32x4*)&cs[4] = *(const f32x4*)(rp + 4); *(f32x4*)&sn[0] = *(const f32x4*)(rp + 32); *(f32x4*)&sn[4] = *(const f32x4*)(rp + 36);
                    float a1[8], a2[8], b1[8], b2[8];
#pragma unroll
                    for (int e = 0; e < 8; ++e) { a1[e] = q1[e] * cs[e] - q2[e] * sn[e]; a2[e] = q2[e] * cs[e] + q1[e] * sn[e];
                        b1[e] = (k1[e] * cs[e] - k2[e] * sn[e]) * 0.125f; b2[e] = (k2[e] * cs[e] + k1[e] * sn[e]) * 0.125f; }
                    *(u32x4*)qp = pack8(a1); *(u32x4*)(qp + 32) = pack8(a2); *(u32x4*)kp = pack8(b1); *(u32x4*)(kp + 32) = pack8(b2);
                    const float w = ex2((float)(63 - tok) * lg);
#pragma unroll
                    for (int e = 0; e < 8; ++e) { b1[e] *= w; b2[e] *= w; }
                    *(LAS u32x4*)(kt + tok * 144 + c * 16) = pack8(b1); *(LAS u32x4*)(kt + tok * 144 + 64 + c * 16) = pack8(b2); }
                const LAS unsigned char* ktl = kt + tr_lane_off<144, false>(lane); const LAS unsigned char* vtl = vtile + tr_lane_off<144, false>(lane);
                float* updp = UPD + (size_t)it * 8192;
#pragma unroll 1
                for (int vh = 0; vh < 2; ++vh) {
#pragma unroll
                    for (int i = 0; i < 8; ++i) { const int row = 8 * i + (lane >> 3), ch = lane & 7;
                        *(LAS u32x4*)(vtile + row * 144 + ch * 16) = *(const u32x4*)(P + (R0 + row) * NIN + C_VB + 128 * h + 64 * vh + 8 * ch); }
#pragma unroll
                    for (int dvb = 0; dvb < 2; ++dvb)
#pragma unroll
                        for (int dkb = 0; dkb < 2; ++dkb) { f32x16 acc;
#pragma unroll
                            for (int r = 0; r < 16; ++r) acc[r] = 0.f;
#pragma unroll
                            for (int s = 0; s < 4; ++s) acc = __builtin_amdgcn_mfma_f32_32x32x16_bf16(tr_frag<144, false>(vtl, 16 * s, 32 * dvb), tr_frag<144, false>(ktl, 16 * s, 32 * dkb), acc, 0, 0, 0);
#pragma unroll
                            for (int r = 0; r < 16; ++r) updp[(64 * vh + 32 * dvb + crow(r) + 4 * (lane >> 5)) * 64 + 32 * dkb + (lane & 31)] = acc[r]; }
                }
            }
            for (int it = gw - 1024; it >= 0 && it < 128; it += NGW) { const int sq = it >> 3, h = it & 7;
                const int lane = fresh_lane();
                const float lg = log2f(1.f - exp2f(-5.f - (float)h));
                LAS float* ql = (LAS float*)(lds + wave * WREG); LAS float* kl = ql + 1024; LAS float* vl = kl + 1024; LAS float* qk = vl + 2048;
                const size_t R0 = (size_t)MP + sq * 16;
#pragma unroll
                for (int t = 0; t < 8; ++t) { const int pi = lane + 64 * t, tok = pi >> 5, d = pi & 31; const float cs = ROPE[(2048 + tok) * 64 + d], sn = ROPE[(2048 + tok) * 64 + 32 + d];
                    const bf16_t* qp = P + (R0 + tok) * NIN + C_QB + 64 * h + d; const bf16_t* kp = P + (R0 + tok) * NIN + C_KB + 64 * h + d;
                    const float q1 = bf2f(qp[0]), q2 = bf2f(qp[32]), k1 = bf2f(kp[0]), k2 = bf2f(kp[32]);
                    ql[tok * 64 + d] = q1 * cs - q2 * sn; ql[tok * 64 + 32 + d] = q2 * cs + q1 * sn;
                    kl[tok * 64 + d] = (k1 * cs - k2 * sn) * 0.125f; kl[tok * 64 + 32 + d] = (k2 * cs + k1 * sn) * 0.125f; }
#pragma unroll
                for (int t = 0; t < 32; ++t) { const int idx = lane + 64 * t, tok = idx >> 7, dv = idx & 127; vl[tok * 128 + dv] = bf2f(P[(R0 + tok) * NIN + C_VB + 128 * h + dv]); }
                LDS_WAIT(); asm volatile("" ::: "memory");
#pragma unroll
                for (int t = 0; t < 4; ++t) { const int idx = lane + 64 * t, i = idx >> 4, j = idx & 15; float s = 0.f;
                    for (int d = 0; d < 64; ++d) s += ql[i * 64 + d] * kl[j * 64 + d];
                    qk[idx] = (j <= i) ? s * ex2((float)(i - j) * lg) : 0.f; }
                LDS_WAIT(); asm volatile("" ::: "memory");
                const float* s0p = args.in[5] + ((size_t)(l * 16 + sq) * 8 + h) * 8192; float* snp = dout + O_RETS + ((size_t)(l * 16 + sq) * 8 + h) * 8192;
                const float g16 = ex2(16.f * lg);
#pragma unroll
                for (int t = 0; t < 16; ++t) { const int idx = lane + 64 * t; kl[idx] *= ex2((float)(15 - (idx >> 6)) * lg); }
                LDS_WAIT(); asm volatile("" ::: "memory");
#pragma unroll 1
                for (int c = 0; c < 2; ++c) { const int dv = lane + 64 * c;
                    float vj[16], cr[16];
#pragma unroll
                    for (int j = 0; j < 16; ++j) { vj[j] = vl[j * 128 + dv]; cr[j] = 0.f; }
                    float s0c[64];
#pragma unroll
                    for (int dk = 0; dk < 64; ++dk) s0c[dk] = s0p[dk * 128 + dv];
#pragma unroll
                    for (int dk = 0; dk < 64; ++dk) { const float s0 = s0c[dk];
                        float sn = g16 * s0;
#pragma unroll
                        for (int j = 0; j < 16; ++j) sn += kl[j * 64 + dk] * vj[j];
                        snp[dk * 128 + dv] = sn;
#pragma unroll
                        for (int i = 0; i < 16; ++i) cr[i] += ql[i * 64 + dk] * s0;
                        if ((dk & 1) == 1) __builtin_amdgcn_sched_barrier(0); }
#pragma unroll
                    for (int i = 0; i < 16; ++i) { float a = cr[i] * ex2((float)(i + 1) * lg);
#pragma unroll
                        for (int j = 0; j <= i; ++j) a += qk[i * 16 + j] * vj[j];
                        vl[i * 128 + dv] = a; }
                }
                LDS_WAIT(); asm volatile("" ::: "memory");
#pragma unroll 4
                for (int i = 0; i < 16; ++i) { const float x0 = vl[i * 128 + lane], x1 = vl[i * 128 + 64 + lane];
                    const float mean = wave_sum(x0 + x1) * (1.f / 128.f); const float d0 = x0 - mean, d1 = x1 - mean;
                    const float var = wave_sum(d0 * d0 + d1 * d1) * (1.f / 128.f); const float rstd = 1.f / sqrtf(var + RET_EPS);
#pragma unroll
                    for (int c = 0; c < 2; ++c) { const int dv = lane + 64 * c; const float g = bf2f(P[(R0 + i) * NIN + C_GR + 128 * h + dv]);
                        OB[(R0 + i) * 3072 + 1024 + 128 * h + dv] = f2bf((c ? d1 : d0) * rstd * g * sigmoidf_(g)); } }
                LDS_WAIT(); asm volatile("" ::: "memory");
            }
            __syncthreads();
            { LAS float* lc = (LAS float*)(lds + AT_LUTC); LAS float* la = (LAS float*)(lds + AT_LUTA); const int tid2 = wave * 64 + fresh_lane();
              for (int i = tid2; i < 16 * 640; i += 512) lc[i] = LUTC[l * 16 * 640 + i];
              for (int i = tid2; i < 16 * 256; i += 512) la[i] = LUTA[i]; }
            __syncthreads();
            { const LAS float* lc = (const LAS float*)(lds + AT_LUTC); const LAS float* la = (const LAS float*)(lds + AT_LUTA);
              LAS unsigned char* vt = lds + wave * AT_VT;
              for (int idx = gw; idx < 4352; idx += NGW) {
                  const int lane = fresh_lane(); const int r32 = lane & 31, hi5 = lane >> 5;
                  if (idx < 4096) { const int f = idx & 2047, half = f & 1, h = (f >> 7) & 15, b = idx >> 11; int n = (f >> 1) & 63; if (b) n = 63 - n;
                      const int c0 = n >= 8 ? n - 8 : 0; const size_t R0 = (size_t)b * SEQ; const int qpos = 64 * n + 32 * half + r32;
                      AttnSrc S{P + (R0 + 64 * c0) * NIN + C_KC + 64 * h, P + (R0 + 64 * c0) * NIN + C_VC + 64 * h, NIN, 0, n - c0 + 1, 64 * c0, nullptr, nullptr, 0, 0, 0};
                      attn_item<false, false>(P + (R0 + qpos) * NIN + C_QC + 64 * h, lc, h * 640 + 575 - qpos + 4 * hi5, 0.f, S, OB + (R0 + qpos) * 3072 + 2048 + 64 * h, true, vt, lane);
                  } else { const int sc = idx - 4096, sq = sc >> 4, h = sc & 15; const int tok = r32 & 15, qpos = 2048 + tok; const size_t R0 = (size_t)MP + sq * 16;
                      const float* ck = args.in[6] + ((size_t)(l * 16 + sq) * 512) * 1024 + 64 * h; const float* cv = args.in[7] + ((size_t)(l * 16 + sq) * 512) * 1024 + 64 * h;
                      AttnSrc S{ck, cv, 1024, 1, 8, 1536, P + R0 * NIN + C_KC + 64 * h, P + R0 * NIN + C_VC + 64 * h, NIN, 16, 2048};
                      attn_item<false, true>(P + (R0 + tok) * NIN + C_QC + 64 * h, lc, h * 640 + 575 - qpos + 4 * hi5, 0.f, S, OB + (R0 + tok) * 3072 + 2048 + 64 * h, r32 < 16, vt, lane); }
              }
              { const int w0 = (NGW >= 2048) ? 256 : 0, nw = NGW - w0;
                if (gw >= w0) for (int k = gw - w0; k < 4224; k += nw) {
                  const int lane = fresh_lane(); const int r32 = lane & 31, hi5 = lane >> 5;
                  if (k < 4096) { const int f = k & 2047, half = f & 1, n = (f >> 1) & 63, h = (f >> 7) & 15, b = k >> 11, g2 = h >> 3;
                      const int c0 = n >= 2 ? n - 2 : 0; const size_t R0 = (size_t)b * SEQ; const int qpos = 64 * n + 32 * half + r32;
                      AttnSrc S{P + (R0 + 64 * c0) * NIN + C_KA + 64 * g2, P + (R0 + 64 * c0) * NIN + C_VA + 64 * g2, NIN, 0, n - c0 + 1, 64 * c0, nullptr, nullptr, 0, 0, 0};
                      attn_item<true, false>(P + (R0 + qpos) * NIN + C_QA + 64 * h, la, h * 256 + 191 - qpos + 4 * hi5, args.in[13][l * 16 + h] * LOG2E, S, OB + (R0 + qpos) * 3072 + 64 * h, true, vt, lane);
                  } else { const int sa = k - 4096, sq = sa >> 3, g2 = (sa >> 2) & 1, w4 = sa & 3; const int h = 8 * g2 + 2 * w4 + (r32 >> 4), tok = r32 & 15, qpos = 2048 + tok;
                      const size_t R0 = (size_t)MP + sq * 16;
                      const float* ck = args.in[3] + ((size_t)(l * 16 + sq) * 128) * 128 + 64 * g2; const float* cv = args.in[4] + ((size_t)(l * 16 + sq) * 128) * 128 + 64 * g2;
                      AttnSrc S{ck, cv, 128, 1, 2, 1920, P + R0 * NIN + C_KA + 64 * g2, P + R0 * NIN + C_VA + 64 * g2, NIN, 16, 2048};
                      attn_item<true, true>(P + (R0 + tok) * NIN + C_QA + 64 * h, la, h * 256 + 191 - qpos + 4 * hi5, args.in[13][l * 16 + h] * LOG2E, S, OB + (R0 + tok) * 3072 + 64 * h, true, vt, lane); }
                } }
            }
            __syncthreads();
            { pg8::Gemm g{MKB, WmqN, DM, DM, 512, (long)256 * DM, 512, 0, 512, 2}; pg8::Order S; S.init(1, 8, 8, G, bxl);
              pg8::EpiOut E{MBT, DM, (long)1024 * DM, (long)256 * DM, nullptr, 0, 0, 0.044194173824159216f * LOG2E, 2};
              pg8::gemm_phase<pg8::EpiOut>(lds, g, S, E, wave); }
            { pg8::Gemm g{WmoT, MVB, DM, DM, 512, 0, 512, (long)256 * DM, 512, 2}; pg8::Order S; S.init(8, 1, 8, G, (bxl + G / 2) % G);
              pg8::EpiOut E{NBT, 1024, (long)DM * 1024, 256, nullptr, 0, 0, 1.f, 2};
              pg8::gemm_phase<pg8::EpiOut>(lds, g, S, E, wave); }
            {
              const int n_sw = 2 * 128 * 16, n_bd = 2 * 512 * 128, n_ssw = 256 * 16, n_sbd = 256 * 128;
              const int gtid2 = gw * 64 + fresh_lane();
              for (int i = gtid2; i < 2 * (n_sw + n_bd + n_ssw + n_sbd); i += gthreads) {
                  int r = i; const int kv = r & 1; r >>= 1; size_t srow; int scol; float* dst;
                  if (r < n_sw) { const int c8 = r & 15, i2 = (r >> 4) & 127, b = r >> 11; srow = (size_t)b * SEQ + 3968 + i2; scol = (kv ? C_VA : C_KA) + 8 * c8;
                      dst = dout + (kv ? O_SWAVP : O_SWAKP) + ((size_t)(l * 2 + b) * 128 + i2) * 128 + 8 * c8; }
                  else if ((r -= n_sw) < n_bd) { const int c8 = r & 127, i2 = (r >> 7) & 511, b = r >> 16; srow = (size_t)b * SEQ + 3584 + i2; scol = (kv ? C_VC : C_KC) + 8 * c8;
                      dst = dout + (kv ? O_BVP : O_BKP) + ((size_t)(l * 2 + b) * 512 + i2) * 1024 + 8 * c8; }
                  else if ((r -= n_bd) < n_ssw) { const int c8 = r & 15, row = r >> 4; srow = (size_t)MP + row; scol = (kv ? C_VA : C_KA) + 8 * c8;
                      dst = dout + (kv ? O_SWAVS : O_SWAKS) + ((size_t)l * 256 + row) * 128 + 8 * c8; }
                  else { r -= n_ssw; const int c8 = r & 127, row = r >> 7; srow = (size_t)MP + row; scol = (kv ? C_VC : C_KC) + 8 * c8;
                      dst = dout + (kv ? O_BVS : O_BKS) + ((size_t)l * 256 + row) * 1024 + 8 * c8; }
                  float f[8]; unpack8(*(const u32x4*)(P + srow * NIN + scol), f);
                  *(f32x4*)dst = (f32x4){f[0], f[1], f[2], f[3]}; *(f32x4*)(dst + 4) = (f32x4){f[4], f[5], f[6], f[7]}; }
            }
        }
        SEAM(pb + 1);

        if (PH_EN(2) && IN(pb + 2)) { const int tid = wave * 64 + fresh_lane(); int gw = gw0; asm volatile("" : "+s"(gw)); const int lane = tid & 63; const int gtid = gw * 64 + lane; (void)gtid; (void)lane;
            for (int i = gtid; i < 16 * 8192; i += gthreads) { const int bh = i >> 13, e = i & 8191, h = bh & 7;
                const float g64 = ex2(64.f * log2f(1.f - exp2f(-5.f - (float)h)));
                const float* up = UPD + (size_t)bh * 64 * 8192 + e; bf16_t* sp = S0T + (size_t)bh * 64 * 8192 + e;
                float s = 0.f;
#pragma unroll 1
                for (int n0 = 0; n0 < 64; n0 += 16) { float u[16];
#pragma unroll
                    for (int j = 0; j < 16; ++j) u[j] = up[(size_t)(n0 + j) * 8192];
#pragma unroll
                    for (int j = 0; j < 16; ++j) { sp[(size_t)(n0 + j) * 8192] = f2bf(s); s = g64 * s + u[j]; } }
                const int dv = e >> 6, dk = e & 63;
                dout[O_RETP + ((size_t)(l * 2 + (bh >> 3)) * 8 + h) * 8192 + dk * 128 + dv] = s; }
        }
        SEAM(pb + 2);

        if (PH_EN(3) && IN(pb + 3)) { const int tid = wave * 64 + fresh_lane(); int gw = gw0; asm volatile("" : "+s"(gw)); const int lane = tid & 63; const int gtid = gw * 64 + lane; (void)gtid; (void)lane;
            for (int it = gw; it < 2048; it += NGW) {
                const int ib = it & 1, n = (it >> 1) & 63, h = (it >> 7) & 7, b = it >> 10;
                const float lg = log2f(1.f - exp2f(-5.f - (float)h));
                const int r32 = lane & 31, hi5 = lane >> 5;
                LAS unsigned char* vtile = lds + wave * WREG;
                const size_t R0 = (size_t)b * SEQ + 64 * n; const size_t rowi = R0 + 32 * ib + r32;
                const int nrow = 32 * (ib + 1);
                for (int i = 0; i < nrow / 4; ++i) { const int row = 4 * i + (lane >> 4), ch = lane & 15;
                    *(LAS u32x4*)(vtile + row * 272 + ch * 16) = *(const u32x4*)(P + (R0 + row) * NIN + C_VB + 128 * h + 8 * ch); }
                bf16x8 qf[4];
#pragma unroll
                for (int d0 = 0; d0 < 4; ++d0) qf[d0] = ldg_frag_bf16(P + rowi * NIN + C_QB + 64 * h + 16 * d0 + 8 * hi5);
                f32x16 o[4];
#pragma unroll
                for (int d = 0; d < 4; ++d)
#pragma unroll
                    for (int r = 0; r < 16; ++r) o[d][r] = 0.f;
                const LAS unsigned char* vtl = vtile + tr_lane_off<272, true>(lane);
                const int ii = 32 * ib + r32;
#pragma unroll 1
                for (int jb = 0; jb <= ib; ++jb) {
                    f32x16 p;
#pragma unroll
                    for (int r = 0; r < 16; ++r) p[r] = 0.f;
#pragma unroll
                    for (int d0 = 0; d0 < 4; ++d0) p = __builtin_amdgcn_mfma_f32_32x32x16_bf16(ldg_frag_bf16(P + (R0 + 32 * jb + r32) * NIN + C_KB + 64 * h + 16 * d0 + 8 * hi5), qf[d0], p, 0, 0, 0);
#pragma unroll
                    for (int r = 0; r < 16; ++r) { const int j = 32 * jb + crow(r) + 4 * hi5; p[r] = (ii >= j) ? p[r] * ex2((float)(ii - j) * lg) : 0.f; }
#pragma unroll
                    for (int s2 = 0; s2 < 2; ++s2) { const bf16x8 pf = pack_frag(p, 8 * s2);
#pragma unroll
                        for (int d = 0; d < 4; ++d) { const LAS unsigned char* base = vtl + (32 * jb + 16 * s2) * 272;
                            o[d] = __builtin_amdgcn_mfma_f32_32x32x16_bf16(tr_frag<272, true>(base, 0, 32 * d), pf, o[d], 0, 0, 0); } }
                }
                { const float sc = ex2((float)(ii + 1) * lg); const bf16_t* sp = S0T + (size_t)((b * 8 + h) * 64 + n) * 8192;
#pragma unroll
                  for (int d0 = 0; d0 < 4; ++d0) { float f[8]; unpack8(__builtin_bit_cast(u32x4, qf[d0]), f);
#pragma unroll
                      for (int e = 0; e < 8; ++e) f[e] *= sc;
                      const bf16x8 qs = __builtin_bit_cast(bf16x8, pack8(f));
#pragma unroll
                      for (int d = 0; d < 4; ++d) o[d] = __builtin_amdgcn_mfma_f32_32x32x16_bf16(ldg_frag_bf16(sp + (32 * d + r32) * 64 + 16 * d0 + 8 * hi5), qs, o[d], 0, 0, 0); } }
                float s = 0.f;
#pragma unroll
                for (int d = 0; d < 4; ++d)
#pragma unroll
                    for (int r = 0; r < 16; ++r) s += o[d][r];
                s = half_sum(s); const float mean = s * (1.f / 128.f);
                float q = 0.f;
#pragma unroll
                for (int d = 0; d < 4; ++d)
#pragma unroll
                    for (int r = 0; r < 16; ++r) { const float dd = o[d][r] - mean; q += dd * dd; }
                q = half_sum(q); const float rstd = 1.f / sqrtf(q * (1.f / 128.f) + RET_EPS);
#pragma unroll
                for (int d = 0; d < 4; ++d)
#pragma unroll
                    for (int rg = 0; rg < 4; ++rg) { const int dv = 32 * d + 8 * rg + 4 * hi5;
                        const u32x2 gw2 = *(const u32x2*)(P + rowi * NIN + C_GR + 128 * h + dv);
                        const float g0 = __uint_as_float(gw2.x << 16), g1 = __uint_as_float(gw2.x & 0xffff0000u), g2 = __uint_as_float(gw2.y << 16), g3 = __uint_as_float(gw2.y & 0xffff0000u);
                        u32x2 w; w.x = pk2((o[d][4 * rg] - mean) * rstd * g0 * sigmoidf_(g0), (o[d][4 * rg + 1] - mean) * rstd * g1 * sigmoidf_(g1));
                        w.y = pk2((o[d][4 * rg + 2] - mean) * rstd * g2 * sigmoidf_(g2), (o[d][4 * rg + 3] - mean) * rstd * g3 * sigmoidf_(g3));
                        *(u32x2*)(OB + rowi * 3072 + 1024 + 128 * h + dv) = w; }
                LDS_WAIT(); asm volatile("" ::: "memory");
            }
        }
        SEAM(pb + 3);

        if (PH_EN(4) && IN(pb + 4)) { const int tid = wave * 64 + fresh_lane(); int gw = gw0; asm volatile("" : "+s"(gw)); const int lane = tid & 63; const int gtid = gw * 64 + lane; (void)gtid; (void)lane;
            { pg8::Order S; S.init_inner(32, 8, 3, G, bxl);
              pg8::Gemm g{OB, WbrT, 3072, 3072, 1024, 1024, 0, 1024, 0, 0}; pg8::EpiGateR E{P, NIN, C_GA, MIX};
              pg8::gemm_phase<pg8::EpiGateR>(lds, g, S, E, wave); }
            sgemm_phase<2>(lds, wave, vcu, G, OB + (size_t)MP * 3072, 3072, WbrT, 3072, 1024, 3, 1024, nullptr, nullptr, MIX + (size_t)MP * DM, DM, P + (size_t)MP * NIN + C_GA, NIN);
        }
        SEAM(pb + 4);

        if (PH_EN(5) && IN(pb + 5)) { const int tid = wave * 64 + fresh_lane(); int gw = gw0; asm volatile("" : "+s"(gw)); const int lane = tid & 63; const int gtid = gw * 64 + lane; (void)gtid; (void)lane;
            pg8::Gemm g{MIX, WmixoT, DM, DM, DM, 0, 0, 0, 0, 0}; pg8::Order S; S.init(32, 8, 1, G, bxl);
            pg8::EpiResid E{l == 0 ? args.in[0] : X, nullptr, X, 0};
            pg8::gemm_phase<pg8::EpiResid>(lds, g, S, E, wave);
            sgemm_phase<0>(lds, wave, vcu, G, MIX + (size_t)MP * DM, DM, WmixoT, DM, DM, 1, 0, l == 0 ? args.in[1] : X + (size_t)MP * DM, X + (size_t)MP * DM, nullptr, 0, nullptr, 0);
        }
        SEAM(pb + 5);

#define LN_PHASE(GI, BI, OUT2) do { const float* gp_ = args.in[GI] + l * DM; const float* bp_ = args.in[BI] + l * DM; \
            for (int m_ = gw; m_ < MA; m_ += NGW) { float* xr_ = X + (size_t)m_ * DM; f32x4 v_[8]; float s_ = 0.f; \
                _Pragma("unroll") for (int j = 0; j < 8; ++j) { v_[j] = ((const f32x4*)xr_)[lane + 64 * j]; s_ += (v_[j][0] + v_[j][1]) + (v_[j][2] + v_[j][3]); } \
                const float mean_ = wave_sum(s_) * (1.f / DM); float q_ = 0.f; \
                _Pragma("unroll") for (int j = 0; j < 8; ++j) { v_[j] = v_[j] - mean_; q_ += (v_[j][0] * v_[j][0] + v_[j][1] * v_[j][1]) + (v_[j][2] * v_[j][2] + v_[j][3] * v_[j][3]); } \
                const float rstd_ = 1.f / sqrtf(wave_sum(q_) * (1.f / DM) + LN_EPS); \
                _Pragma("unroll") for (int j = 0; j < 8; ++j) { const f32x4 gg_ = ((const f32x4*)gp_)[lane + 64 * j], bb_ = ((const f32x4*)bp_)[lane + 64 * j]; const f32x4 o_ = v_[j] * rstd_ * gg_ + bb_; \
                    ((f32x4*)xr_)[lane + 64 * j] = o_; if (OUT2) ((f32x4*)((OUT2) + (size_t)m_ * DM))[lane + 64 * j] = o_; \
                    u32x2 w_; w_.x = pk2(o_[0], o_[1]); w_.y = pk2(o_[2], o_[3]); ((u32x2*)(XB + (size_t)m_ * DM))[lane + 64 * j] = w_; } } } while (0)

        if (PH_EN(6) && IN(pb + 6)) { const int tid = wave * 64 + fresh_lane(); int gw = gw0; asm volatile("" : "+s"(gw)); const int lane = tid & 63; const int gtid = gw * 64 + lane; (void)gtid; (void)lane; LN_PHASE(19, 20, (float*)nullptr); }
        SEAM(pb + 6);

        if (PH_EN(7) && IN(pb + 7)) { const int tid = wave * 64 + fresh_lane(); int gw = gw0; asm volatile("" : "+s"(gw)); const int lane = tid & 63; const int gtid = gw * 64 + lane; (void)gtid; (void)lane;
            { pg8::Gemm g{XB, MBT, DM, DM, DM, (long)SEQ * DM, 0, (long)1024 * DM, 0, 0}; pg8::Order S; S.init(16, 4, 2, G, bxl);
              pg8::EpiSoftmax E{PM, 1024, (long)SEQ * 1024};
              pg8::gemm_phase<pg8::EpiSoftmax>(lds, g, S, E, wave); }
            sgemm_phase<1>(lds, wave, vcu, G, XB + (size_t)MP * DM, DM, WmqT, DM, DM, 1, 0, nullptr, nullptr, QM, DM, nullptr, 0);
        }
        SEAM(pb + 7);

        if (PH_EN(8) && IN(pb + 8)) { const int tid = wave * 64 + fresh_lane(); int gw = gw0; asm volatile("" : "+s"(gw)); const int lane = tid & 63; const int gtid = gw * 64 + lane; (void)gtid; (void)lane;
            for (int it = vcu; it < 64; it += G) { const int sq = it >> 2, hd = it & 3;
                LAS float* Sl = (LAS float*)lds;
                LAS bf16_t* Pl = (LAS bf16_t*)(lds + 16 * 260 * 4);
                const int c16 = lane & 15, fq = lane >> 4;
                const float* ck = args.in[9] + ((size_t)(l * 16 + sq) * 256) * DM + 512 * hd; const float* cv = args.in[10] + ((size_t)(l * 16 + sq) * 256) * DM + 512 * hd;
                const bf16_t* qp = QM + (size_t)(sq * 16 + c16) * DM + 512 * hd;
#pragma unroll 1
                for (int kb2 = 0; kb2 < 2; ++kb2) { const int kb = 2 * wave + kb2; f32x4 acc = {0.f, 0.f, 0.f, 0.f};
#pragma unroll
                    for (int ds = 0; ds < 16; ++ds) acc = __builtin_amdgcn_mfma_f32_16x16x32_bf16(ldg_frag_bf16(qp + 32 * ds + 8 * fq), ldg_frag_f32(ck + (size_t)(16 * kb + c16) * DM + 32 * ds + 8 * fq), acc, 0, 0, 0);
#pragma unroll
                    for (int r = 0; r < 4; ++r) Sl[(4 * fq + r) * 260 + 16 * kb + c16] = acc[r] * (0.044194173824159216f * LOG2E); }
                __syncthreads();
#pragma unroll
                for (int rr = 0; rr < 2; ++rr) { const int q = 2 * wave + rr; float v[4];
#pragma unroll
                    for (int j = 0; j < 4; ++j) v[j] = Sl[q * 260 + lane + 64 * j];
                    const float mx = wave_max(fmaxf(fmaxf(v[0], v[1]), fmaxf(v[2], v[3])));
#pragma unroll
                    for (int j = 0; j < 4; ++j) v[j] = ex2(v[j] - mx);
                    const float inv = 1.f / wave_sum((v[0] + v[1]) + (v[2] + v[3]));
#pragma unroll
                    for (int j = 0; j < 4; ++j) Pl[q * 264 + lane + 64 * j] = f2bf(v[j] * inv); }
                __syncthreads();
#pragma unroll 1
                for (int db = 0; db < 4; ++db) { const int dcol = 64 * wave + 16 * db + c16; f32x4 acc = {0.f, 0.f, 0.f, 0.f};
#pragma unroll
                    for (int ks = 0; ks < 8; ++ks) { float f[8];
#pragma unroll
                        for (int j = 0; j < 8; ++j) f[j] = cv[(size_t)(32 * ks + 8 * fq + j) * DM + dcol];
                        const bf16x8 pa = *(const LAS bf16x8*)(Pl + c16 * 264 + 32 * ks + 8 * fq);
                        acc = __builtin_amdgcn_mfma_f32_16x16x32_bf16(pa, __builtin_bit_cast(bf16x8, pack8(f)), acc, 0, 0, 0); }
#pragma unroll
                    for (int r = 0; r < 4; ++r) OM[(size_t)(sq * 16 + 4 * fq + r) * DM + 512 * hd + dcol] = f2bf(acc[r]); }
                __syncthreads();
            }
        }
        SEAM(pb + 8);

        if (PH_EN(9) && IN(pb + 9)) { const int tid = wave * 64 + fresh_lane(); int gw = gw0; asm volatile("" : "+s"(gw)); const int lane = tid & 63; const int gtid = gw * 64 + lane; (void)gtid; (void)lane;
            { pg8::Gemm g{PM, NBT, 1024, 1024, 1024, (long)SEQ * 1024, 0, (long)DM * 1024, 0, 0}; pg8::Order S; S.init(16, 8, 2, G, bxl);
              pg8::EpiResid E{X, nullptr, X, SEQ};
              pg8::gemm_phase<pg8::EpiResid>(lds, g, S, E, wave); }
            sgemm_phase<0>(lds, wave, vcu, G, OM, DM, WmoT, DM, DM, 1, 0, X + (size_t)MP * DM, X + (size_t)MP * DM, nullptr, 0, nullptr, 0);
        }
        SEAM(pb + 9);

        if (PH_EN(10) && IN(pb + 10)) { const int tid = wave * 64 + fresh_lane(); int gw = gw0; asm volatile("" : "+s"(gw)); const int lane = tid & 63; const int gtid = gw * 64 + lane; (void)gtid; (void)lane; LN_PHASE(25, 26, (float*)nullptr); }
        SEAM(pb + 10);

        if (PH_EN(11) && IN(pb + 11)) { const int tid = wave * 64 + fresh_lane(); int gw = gw0; asm volatile("" : "+s"(gw)); const int lane = tid & 63; const int gtid = gw * 64 + lane; (void)gtid; (void)lane;
            pg8::Gemm g{XB, WfinT, DM, DM, DM, 0, 0, 0, 0, 0}; pg8::Order S; S.init(33, 44, 1, G, bxl);
            pg8::EpiOut E{U, FF2, 0, 0, nullptr, 0, 0, 1.f, 0};
            pg8::gemm_phase<pg8::EpiOut>(lds, g, S, E, wave);
        }
        SEAM(pb + 11);

        if (PH_EN(12) && IN(pb + 12)) { const int tid = wave * 64 + fresh_lane(); int gw = gw0; asm volatile("" : "+s"(gw)); const int lane = tid & 63; const int gtid = gw * 64 + lane; (void)gtid; (void)lane;
            const float* cw = args.in[28] + (size_t)l * 3 * FF2; const float* cb = args.in[29] + (size_t)l * FF2;
            for (int it = gw; it < 528 * 11; it += NGW) { const int rr = it / 11, cbk = it - rr * 11; const int j0 = cbk * 512 + lane * 8; const int t0 = rr * 16;
                float w0[16], w1[16], w2[16], bb[16], um2[16], um1[16];
#pragma unroll
                for (int p2 = 0; p2 < 2; ++p2)
#pragma unroll
                    for (int e4 = 0; e4 < 2; ++e4) { const int col = j0 + p2 * FF + 4 * e4;
                        *(f32x4*)&w0[8 * p2 + 4 * e4] = *(const f32x4*)(cw + col); *(f32x4*)&w1[8 * p2 + 4 * e4] = *(const f32x4*)(cw + FF2 + col);
                        *(f32x4*)&w2[8 * p2 + 4 * e4] = *(const f32x4*)(cw + 2 * FF2 + col); *(f32x4*)&bb[8 * p2 + 4 * e4] = *(const f32x4*)(cb + col); }
                if (t0 >= MP) { const float* st = args.in[8] + ((size_t)(l * 16 + (t0 - MP) / 16) * 2) * FF2;
#pragma unroll
                    for (int p2 = 0; p2 < 2; ++p2)
#pragma unroll
                        for (int e4 = 0; e4 < 2; ++e4) { const int col = j0 + p2 * FF + 4 * e4; *(f32x4*)&um2[8 * p2 + 4 * e4] = *(const f32x4*)(st + col); *(f32x4*)&um1[8 * p2 + 4 * e4] = *(const f32x4*)(st + FF2 + col); }
                } else if ((t0 & (SEQ - 1)) == 0) {
#pragma unroll
                    for (int e = 0; e < 16; ++e) { um2[e] = 0.f; um1[e] = 0.f; }
                } else {
#pragma unroll
                    for (int p2 = 0; p2 < 2; ++p2) { float f[8]; unpack8(*(const u32x4*)(U + (size_t)(t0 - 2) * FF2 + j0 + p2 * FF), f);
#pragma unroll
                        for (int e = 0; e < 8; ++e) um2[8 * p2 + e] = f[e];
                        unpack8(*(const u32x4*)(U + (size_t)(t0 - 1) * FF2 + j0 + p2 * FF), f);
#pragma unroll
                        for (int e = 0; e < 8; ++e) um1[8 * p2 + e] = f[e]; }
                }
#pragma unroll 4
                for (int t = t0; t < t0 + 16; ++t) { float u0[16];
#pragma unroll
                    for (int p2 = 0; p2 < 2; ++p2) { float f[8]; unpack8(*(const u32x4*)(U + (size_t)t * FF2 + j0 + p2 * FF), f);
#pragma unroll
                        for (int e = 0; e < 8; ++e) u0[8 * p2 + e] = f[e]; }
                    float hv[8];
#pragma unroll
                    for (int e = 0; e < 8; ++e) { const float cg = w0[e] * um2[e] + w1[e] * um1[e] + w2[e] * u0[e] + bb[e]; const float cv = w0[8 + e] * um2[8 + e] + w1[8 + e] * um1[8 + e] + w2[8 + e] * u0[8 + e] + bb[8 + e];
                        hv[e] = gelu_erf(cg) * cv; }
                    *(u32x4*)(H + (size_t)t * FF + j0) = pack8(hv);
#pragma unroll
                    for (int e = 0; e < 16; ++e) { um2[e] = um1[e]; um1[e] = u0[e]; } }
            }
            for (int i = gtid; i < 36 * (FF2 / 8); i += gthreads) { const int c8 = i % (FF2 / 8), r = i / (FF2 / 8); size_t srow; float* dst;
                if (r < 4) { const int b = r >> 1, k = r & 1; srow = (size_t)b * SEQ + 4094 + k; dst = dout + O_FCP + ((size_t)(l * 2 + b) * 2 + k) * FF2 + 8 * c8; }
                else { const int r2 = r - 4, sq = r2 >> 1, k = r2 & 1; srow = (size_t)MP + sq * 16 + 14 + k; dst = dout + O_FCS + ((size_t)(l * 16 + sq) * 2 + k) * FF2 + 8 * c8; }
                float f[8]; unpack8(*(const u32x4*)(U + srow * FF2 + 8 * c8), f);
                *(f32x4*)dst = (f32x4){f[0], f[1], f[2], f[3]}; *(f32x4*)(dst + 4) = (f32x4){f[4], f[5], f[6], f[7]}; }
        }
        SEAM(pb + 12);

        if (PH_EN(13) && IN(pb + 13)) { const int tid = wave * 64 + fresh_lane(); int gw = gw0; asm volatile("" : "+s"(gw)); const int lane = tid & 63; const int gtid = gw * 64 + lane; (void)gtid; (void)lane;
            pg8::Gemm g{H, WfoutT, FF, FF, FF, 0, 0, 0, 0, 0}; pg8::Order S; S.init(32, 8, 1, G, bxl);
            pg8::EpiResid E{X, nullptr, X, 0};
            pg8::gemm_phase<pg8::EpiResid>(lds, g, S, E, wave);
            sgemm_phase<0>(lds, wave, vcu, G, H + (size_t)MP * FF, FF, WfoutT, FF, FF, 1, 0, X + (size_t)MP * DM, X + (size_t)MP * DM, nullptr, 0, nullptr, 0);
        }
        SEAM(pb + 13);

        if (PH_EN(14) && IN(pb + 14)) { const int tid = wave * 64 + fresh_lane(); int gw = gw0; asm volatile("" : "+s"(gw)); const int lane = tid & 63; const int gtid = gw * 64 + lane; (void)gtid; (void)lane; float* o2 = (l == 1) ? dout + O_Y : nullptr; LN_PHASE(31, 32, o2); }
        SEAM(pb + 14);
    }
#if defined(PROBE_MASK)
    if (blockIdx.x == 0 && wave == 0 && fresh_lane() == 0) { const unsigned long long t0_ = __builtin_amdgcn_s_memrealtime(); while (__builtin_amdgcn_s_memrealtime() - t0_ < (unsigned long long)(PROBE_AMP) * pr_acc) __builtin_amdgcn_s_sleep(8); }
#endif
#if defined(DBG_OFF)
    if (lo == NPHASE) { const int gt = (gw0 * 64 + fresh_lane());
        for (size_t i = gt; i < O_END; i += (size_t)gthreads) { const bool in = i >= (size_t)(DBG_OFF) && i < (size_t)(DBG_OFF) + (size_t)(DBG_LEN); dout[i] = in ? dout[i] * (float)(DBG_SCALE) : 0.f; } }
#endif
#undef IN
#undef SEAM
}

extern "C" void kernel_launch(void* const* d_in, const int* in_sizes, int n_in, void* d_out, int out_size, void* d_ws, size_t ws_size, hipStream_t stream) {
    static int grid = 0;
    if (grid == 0) {
        if (n_in != 33 || out_size != (int)O_END || ws_size < WS_END) { fprintf(stderr, "kernel_launch: unexpected shapes (n_in %d, out %d, ws %zu)\n", n_in, out_size, ws_size); grid = -1; return; }
        int dev = 0, cus = 0;
        if (hipGetDevice(&dev) != hipSuccess || hipDeviceGetAttribute(&cus, hipDeviceAttributeMultiprocessorCount, dev) != hipSuccess) { grid = -1; return; }
        if (hipFuncSetAttribute((const void*)enc_fwd, hipFuncAttributeMaxDynamicSharedMemorySize, LDS_BYTES) != hipSuccess) { fprintf(stderr, "kernel_launch: hipFuncSetAttribute failed\n"); grid = -1; return; }
        int per_cu = 0;
        if (hipOccupancyMaxActiveBlocksPerMultiprocessor(&per_cu, (const void*)enc_fwd, 512, LDS_BYTES) != hipSuccess || per_cu < 1) fprintf(stderr, "kernel_launch: occupancy query reports %d\n", per_cu);
        (void)hipGetLastError();
        grid = cus;
    }
    if (grid < 0) return;
    (void)hipMemsetAsync((char*)d_ws + WS_CTL, 0, CTL_ZERO_BYTES, stream);
    Args a{};
    for (int i = 0; i < 33; ++i) a.in[i] = (const float*)d_in[i];
    a.out = (float*)d_out; a.ws = (unsigned char*)d_ws;
#if N_LAUNCH_MODE == 0
    a.ph_lo = 0; a.ph_hi = NPHASE;
    hipLaunchKernelGGL(enc_fwd, dim3(grid), dim3(512), LDS_BYTES, stream, a);
#else
    for (int p = 0; p < NPHASE; ++p) { a.ph_lo = p; a.ph_hi = p + 1; hipLaunchKernelGGL(enc_fwd, dim3(grid), dim3(512), LDS_BYTES, stream, a); }
#if defined(DBG_OFF)
    a.ph_lo = NPHASE; a.ph_hi = NPHASE + 1; hipLaunchKernelGGL(enc_fwd, dim3(grid), dim3(512), LDS_BYTES, stream, a);
#endif
#endif
}
```
